# Optimizing an MI355X kernel written in HIP

```python
import jax, jax.numpy as jnp
from jax import lax
import numpy as np

D_MODEL = 2048
BATCH = 4
SEQ = 4096
DEPTH = 4

CHUNK = 64
LEFT_CHUNKS = 8
BAND_CHUNKS = LEFT_CHUNKS + 1
Q_BLOCK = 128

A_HEAD_DIM = 128
A_HEADS = D_MODEL // (2 * A_HEAD_DIM)
A_WIDTH = A_HEADS * A_HEAD_DIM
REL_CLIP = 128

B_NOPE = 128
B_ROPE = 64
B_V = 128
B_HEADS = D_MODEL // (2 * B_V)
B_WIDTH = B_HEADS * B_V
Q_LORA = 768
KV_LORA = 512
ROPE_THETA = 10000.0

MIX_WIDTH = A_WIDTH + B_WIDTH
IN_SIZES = (A_WIDTH, A_WIDTH, A_WIDTH, Q_LORA, KV_LORA, B_ROPE)
IN_WIDTH = sum(IN_SIZES)
IN_SPLITS = tuple(int(v) for v in np.cumsum(IN_SIZES)[:-1])

N_MEM = 256
X_HEADS = 4
X_HEAD_DIM = 128
X_WIDTH = X_HEADS * X_HEAD_DIM

D_FF = 256 * (-(-8 * D_MODEL // (3 * 256)))

EPS = 1e-6

kernel_name = "hybrid_chunked_relpos_mla_memory_encoder"


def rms_norm(x, g):
    xf = x.astype(jnp.float32)
    y = xf * lax.rsqrt(jnp.mean(xf * xf, axis=-1, keepdims=True) + EPS)
    return y.astype(x.dtype) * g


def softmax_f32(s):
    return jax.nn.softmax(s.astype(jnp.float32), axis=-1)


def rope_tables(positions):
    half = B_ROPE // 2
    inv = ROPE_THETA ** (-jnp.arange(half, dtype=jnp.float32) / half)
    ang = positions.astype(jnp.float32)[..., None] * inv
    return jnp.cos(ang), jnp.sin(ang)


def apply_rope(x, cos, sin):
    half = x.shape[-1] // 2
    x1, x2 = x[..., :half], x[..., half:]
    c = cos.astype(x.dtype)
    s = sin.astype(x.dtype)
    return jnp.concatenate([x1 * c - x2 * s, x1 * s + x2 * c], axis=-1)


def chunked_relpos_attention(q, k, v, rel_bias):
    b, s, h, dh = q.shape
    nc = s // CHUNK
    qc = q.reshape(b, nc, CHUNK, h, dh)
    pad = ((0, 0), (LEFT_CHUNKS * CHUNK, 0), (0, 0), (0, 0))
    kp = jnp.pad(k, pad).reshape(b, nc + LEFT_CHUNKS, CHUNK, h, dh)
    vp = jnp.pad(v, pad).reshape(b, nc + LEFT_CHUNKS, CHUNK, h, dh)
    kb = jnp.concatenate([kp[:, j:j + nc] for j in range(BAND_CHUNKS)], axis=2)
    vb = jnp.concatenate([vp[:, j:j + nc] for j in range(BAND_CHUNKS)], axis=2)
    scores = jnp.einsum('bnqhd,bnkhd->bhnqk', qc, kb).astype(jnp.float32) * (dh ** -0.5)
    qpos = LEFT_CHUNKS * CHUNK + jnp.arange(CHUNK)
    kpos = jnp.arange(BAND_CHUNKS * CHUNK)
    rel = jnp.clip(qpos[:, None] - kpos[None, :], -REL_CLIP, REL_CLIP) + REL_CLIP
    bias = rel_bias[:, rel].astype(jnp.float32)
    kglob = jnp.arange(nc)[:, None] * CHUNK + kpos[None, :] - LEFT_CHUNKS * CHUNK
    valid = kglob >= 0
    scores = scores + bias[None, :, None]
    scores = jnp.where(valid[None, None, :, None, :], scores, -jnp.inf)
    p = softmax_f32(scores).astype(v.dtype)
    o = jnp.einsum('bhnqk,bnkhd->bnqhd', p, vb)
    return o.reshape(b, s, h * dh)


def mla_attention(q_lat, kv_lat, k_rope, cos, sin, q_norm, kv_norm, w_uq, w_ukv):
    b, s, _ = q_lat.shape
    q = (rms_norm(q_lat, q_norm) @ w_uq).reshape(b, s, B_HEADS, B_NOPE + B_ROPE)
    q_nope = q[..., :B_NOPE]
    q_pe = apply_rope(q[..., B_NOPE:], cos[:, :, None], sin[:, :, None])
    kv = (rms_norm(kv_lat, kv_norm) @ w_ukv).reshape(b, s, B_HEADS, B_NOPE + B_V)
    k_nope, v = kv[..., :B_NOPE], kv[..., B_NOPE:]
    k_pe = apply_rope(k_rope, cos, sin)
    nb = s // Q_BLOCK
    qn_blocks = q_nope.reshape(b, nb, Q_BLOCK, B_HEADS, B_NOPE).transpose(1, 0, 2, 3, 4)
    qr_blocks = q_pe.reshape(b, nb, Q_BLOCK, B_HEADS, B_ROPE).transpose(1, 0, 2, 3, 4)
    k_chunk = jnp.arange(s) // CHUNK
    scale = (B_NOPE + B_ROPE) ** -0.5

    def block(args):
        i, qn, qr = args
        sc = (jnp.einsum('bqhd,bkhd->bhqk', qn, k_nope)
              + jnp.einsum('bqhr,bkr->bhqk', qr, k_pe)).astype(jnp.float32) * scale
        q_chunk = (i * Q_BLOCK + jnp.arange(Q_BLOCK)) // CHUNK
        allowed = k_chunk[None, :] <= q_chunk[:, None]
        sc = jnp.where(allowed[None, None], sc, -jnp.inf)
        p = softmax_f32(sc).astype(v.dtype)
        return jnp.einsum('bhqk,bkhd->bqhd', p, v)

    o = lax.map(block, (jnp.arange(nb), qn_blocks, qr_blocks))
    return o.transpose(1, 0, 2, 3, 4).reshape(b, s, B_WIDTH)


def memory_cross_attention(h, mem_n, w_xq, w_xkv, w_xo):
    b, s, _ = h.shape
    m = mem_n.shape[1]
    q = (h @ w_xq).reshape(b, s, X_HEADS, X_HEAD_DIM)
    kv = (mem_n @ w_xkv).reshape(b, m, 2, X_HEADS, X_HEAD_DIM)
    k, v = kv[:, :, 0], kv[:, :, 1]
    sc = jnp.einsum('bqhd,bmhd->bhqm', q, k).astype(jnp.float32) * (X_HEAD_DIM ** -0.5)
    p = softmax_f32(sc).astype(v.dtype)
    o = jnp.einsum('bhqm,bmhd->bqhd', p, v).reshape(b, s, X_WIDTH)
    return o @ w_xo


def swiglu(h, w_gate, w_up, w_down):
    return (jax.nn.silu(h @ w_gate) * (h @ w_up)) @ w_down


def setup_inputs(seed: int = 0) -> dict:
    key = jax.random.key(seed)
    ks = jax.random.split(key, 24)
    f32 = jnp.float32

    def dense(k, shape):
        return jax.random.normal(k, shape, f32) * (shape[-2] ** -0.5)

    def gain(k, shape):
        return 1.0 + 0.02 * jax.random.normal(k, shape, f32)

    x = jax.random.normal(ks[0], (BATCH, SEQ, D_MODEL), f32)
    mem = jax.random.normal(ks[1], (BATCH, N_MEM, D_MODEL), f32)
    offset = jax.random.randint(ks[2], (BATCH, 1), 0, 4096, dtype=jnp.int32)
    positions = (offset + jnp.arange(SEQ, dtype=jnp.int32)[None, :]).astype(jnp.int32)
    return {
        "x": x,
        "mem": mem,
        "positions": positions,
        "norm_mix": gain(ks[3], (DEPTH, D_MODEL)),
        "w_in": dense(ks[4], (DEPTH, D_MODEL, IN_WIDTH)),
        "rel_bias": 0.1 * jax.random.normal(ks[5], (DEPTH, A_HEADS, 2 * REL_CLIP + 1), f32),
        "q_norm": gain(ks[6], (DEPTH, Q_LORA)),
        "kv_norm": gain(ks[7], (DEPTH, KV_LORA)),
        "w_uq": dense(ks[8], (DEPTH, Q_LORA, B_HEADS * (B_NOPE + B_ROPE))),
        "w_ukv": dense(ks[9], (DEPTH, KV_LORA, B_HEADS * (B_NOPE + B_V))),
        "w_out": dense(ks[10], (DEPTH, MIX_WIDTH, D_MODEL)),
        "norm_mem": gain(ks[11], (DEPTH, D_MODEL)),
        "mem_norm": gain(ks[12], (D_MODEL,)),
        "w_xq": dense(ks[13], (DEPTH, D_MODEL, X_WIDTH)),
        "w_xkv": dense(ks[14], (DEPTH, D_MODEL, 2 * X_WIDTH)),
        "w_xo": dense(ks[15], (DEPTH, X_WIDTH, D_MODEL)),
        "norm_ffn": gain(ks[16], (DEPTH, D_MODEL)),
        "w_gate": dense(ks[17], (DEPTH, D_MODEL, D_FF)),
        "w_up": dense(ks[18], (DEPTH, D_MODEL, D_FF)),
        "w_down": dense(ks[19], (DEPTH, D_FF, D_MODEL)),
        "norm_final": gain(ks[20], (D_MODEL,)),
    }


def reference(x, mem, positions, norm_mix, w_in, rel_bias, q_norm, kv_norm, w_uq, w_ukv,
              w_out, norm_mem, mem_norm, w_xq, w_xkv, w_xo, norm_ffn, w_gate, w_up,
              w_down, norm_final):
    b, s, _ = x.shape
    cos, sin = rope_tables(positions)
    mem_n = rms_norm(mem, mem_norm)
    for l in range(DEPTH):
        h = rms_norm(x, norm_mix[l])
        proj = h @ w_in[l]
        qa, ka, va, q_lat, kv_lat, k_rope = jnp.split(proj, IN_SPLITS, axis=-1)
        shp = (b, s, A_HEADS, A_HEAD_DIM)
        oa = chunked_relpos_attention(qa.reshape(shp), ka.reshape(shp), va.reshape(shp),
                                      rel_bias[l])
        ob = mla_attention(q_lat, kv_lat, k_rope, cos, sin, q_norm[l], kv_norm[l],
                           w_uq[l], w_ukv[l])
        x = x + jnp.concatenate([oa, ob], axis=-1) @ w_out[l]
        h = rms_norm(x, norm_mem[l])
        x = x + memory_cross_attention(h, mem_n, w_xq[l], w_xkv[l], w_xo[l])
        h = rms_norm(x, norm_ffn[l])
        x = x + swiglu(h, w_gate[l], w_up[l], w_down[l])
    return rms_norm(x, norm_final)
```

```cpp
#define SLOT_EXTRA 3008
#define SLOT_A 6500
#define SLOT_D 2500
#include <hip/hip_runtime.h>
#include <hip/hip_cooperative_groups.h>
#include <cstdio>
#include <cstdint>
namespace cg = cooperative_groups;
namespace pg8 {
#define PG8_LAS __attribute__((address_space(3)))
typedef unsigned short bf16_t;
typedef short bf16x8 __attribute__((ext_vector_type(8)));
typedef float f32x4 __attribute__((ext_vector_type(4)));
typedef unsigned u32x4 __attribute__((ext_vector_type(4)));
constexpr int BM = 256, BK = 64, HALF = 128, HTB = HALF * BK * 2  , STAGE_BYTES = 8 * HTB, NXCD = 8, WGM = 8;

__host__ __device__ __forceinline__ int lds_byte(int r, int c) { const int st = (r >> 4) * 2 + (c >> 5), rr = r & 15, cc = c & 31, ob = rr * 64 + cc * 2; return st * 1024 + (ob ^ (((ob >> 9) & 1) << 5)); }
__host__ __device__ __forceinline__ void stage_rc(int b, int& R, int& C) { const int st = b / 1024, sb = b % 1024, swz = sb ^ (((sb >> 9) & 1) << 5); R = (st >> 1) * 16 + swz / 64; C = (st & 1) * 32 + (swz % 64) / 2; }
__host__ __device__ __forceinline__ int perm32(int rho) { const int n = rho >> 4, i = rho & 15; return 8 * (i >> 2) + 4 * n + (i & 3); }

struct Unit { int pm, pn; };
struct Gemm { const bf16_t* A; const bf16_t* Bt; int M, N, K, lda, ldb; };

struct StaticOrder {
    int nM, nN, nwg, G, c, pn_fast;
    __host__ __device__ void init(int M, int N, int G_, int c_, int pn_fast_ = 0) { nM = M / BM; nN = N / BM; nwg = nM * nN; G = G_; c = c_; pn_fast = pn_fast_; }
    __host__ __device__ bool next(int i, Unit& u) const {
        const long L = (long)i * G + c; if (L >= nwg) return false;
        int wgid = (int)L; { const int q = nwg / NXCD, r = nwg % NXCD, xcd = wgid % NXCD, off = wgid / NXCD; wgid = (xcd < r ? xcd * (q + 1) : r * (q + 1) + (xcd - r) * q) + off; }
        const int nig = WGM * nN, gid = wgid / nig, fm = gid * WGM, gsz = (nM - fm) < WGM ? (nM - fm) : WGM;
        if (pn_fast) { u.pm = fm + (wgid % nig) / nN; u.pn = (wgid % nig) % nN; } else { u.pm = fm + ((wgid % nig) % gsz); u.pn = (wgid % nig) / gsz; }
        return true;
    }
    __device__ __forceinline__ void a_ready(const Unit&) const {}
    __device__ __forceinline__ void done(const Unit&) const {}
};
__device__ __forceinline__ unsigned cvt_pk_bf16(float lo, float hi) { unsigned r; asm volatile("v_cvt_pk_bf16_f32 %0, %1, %2" : "=v"(r) : "v"(lo), "v"(hi)); return r; }
typedef _Float16 f16x8 __attribute__((ext_vector_type(8)));
template <class Epi, class Sched, bool ALIGN_EPI = false, bool SP2 = false, bool F16 = false>
__device__ __forceinline__ void gemm_phase(PG8_LAS unsigned char* lds, const Gemm g, const Sched& S, const Epi& E) {
    int tid = threadIdx.x; asm volatile("" : "+v"(tid));
    const int wid = __builtin_amdgcn_readfirstlane(tid >> 6), lane = tid & 63, wr = wid >> 2, wc = wid & 3, fr = lane & 15, fq = lane >> 4;
    const int K = g.K, nt = K / BK;
    unsigned voffA[2], voffB[2];
#pragma unroll
    for (int i = 0; i < 2; ++i) { int R, C; stage_rc(tid * 16 + i * 8192, R, C); const int Rb = Epi::PERM ? ((R & ~31) + perm32(R & 31)) : R;
        voffA[i] = (unsigned)(R * g.lda + C) * 2u; voffB[i] = (unsigned)(Rb * g.ldb + C) * 2u; }
    const size_t kstep = (size_t)(BK * 2);
    const size_t hstepA = (size_t)HALF * g.lda * 2, hstepB = (size_t)HALF * g.ldb * 2;
    const size_t tstepA = 2 * hstepA, tstepB = 2 * hstepB;
    const unsigned ldsw = (unsigned)wid * 1024u;
    const int aoff = lds_byte(wr * 64 + fr, fq * 8), boff = lds_byte(wc * 32 + fr, fq * 8);
#define PG8_SA(b, h) (((b) * 2 + (h)) * HTB)
#define PG8_SB(b, h) ((4 + (b) * 2 + (h)) * HTB)
#define PG8_STAGE(bufoff, gbase, voff) do { _Pragma("unroll") for (int _i = 0; _i < 2; ++_i) \
        __builtin_amdgcn_global_load_lds((const unsigned*)((const char*)(gbase) + (voff)[_i]), (PG8_LAS unsigned*)(lds + (bufoff) + ldsw + _i * 8192), 16, 0, 0); } while (0)
#define PG8_LDA(dst, b, h) do { _Pragma("unroll") for (int m = 0; m < 4; ++m) _Pragma("unroll") for (int k = 0; k < 2; ++k) dst[m][k] = *(const PG8_LAS bf16x8*)(lds + PG8_SA(b, h) + aoff + m * 2048 + k * 1024); } while (0)
#define PG8_LDB(dst, b, h) do { _Pragma("unroll") for (int n = 0; n < 2; ++n) _Pragma("unroll") for (int k = 0; k < 2; ++k) dst[n][k] = *(const PG8_LAS bf16x8*)(lds + PG8_SB(b, h) + boff + n * 2048 + k * 1024); } while (0)
#define PG8_MMA(ai, bj, At, Bt) do { __builtin_amdgcn_s_setprio(1); _Pragma("unroll") for (int m = 0; m < 4; ++m) _Pragma("unroll") for (int n = 0; n < 2; ++n) _Pragma("unroll") for (int k = 0; k < 2; ++k) \
        { if constexpr (F16) acc[ai][bj][m][n] = __builtin_amdgcn_mfma_f32_16x16x32_f16(__builtin_bit_cast(f16x8, Bt[n][k]), __builtin_bit_cast(f16x8, At[m][k]), acc[ai][bj][m][n], 0, 0, 0); \
          else acc[ai][bj][m][n] = __builtin_amdgcn_mfma_f32_16x16x32_bf16(Bt[n][k], At[m][k], acc[ai][bj][m][n], 0, 0, 0); } __builtin_amdgcn_s_setprio(0); } while (0)
#define PG8_WAIT_V(n) asm volatile("s_waitcnt vmcnt(" #n ")" ::: "memory")
#define PG8_WAIT_L(n) asm volatile("s_waitcnt lgkmcnt(" #n ")" ::: "memory")
#define PG8_BAR __builtin_amdgcn_s_barrier()
#define PG8_SCHED __builtin_amdgcn_sched_barrier(0)
    Unit cur, nxt; int ui = 0;
    if (!S.next(0, cur)) return;
    f32x4 acc[2][2][4][2];
#pragma unroll
    for (int a = 0; a < 2; ++a)
#pragma unroll
        for (int b = 0; b < 2; ++b)
#pragma unroll
            for (int m = 0; m < 4; ++m)
#pragma unroll
                for (int n = 0; n < 2; ++n) acc[a][b][m][n] = (f32x4){0.f, 0.f, 0.f, 0.f};
    bf16x8 At[4][2], B0[2][2], B1[2][2];
    const char* cA = (const char*)g.A + (size_t)cur.pm * tstepA; const char* cB = (const char*)g.Bt + (size_t)cur.pn * tstepB;
    S.a_ready(cur);
    if constexpr (SP2) {
        PG8_STAGE(PG8_SB(0, 0), cB, voffB); PG8_STAGE(PG8_SB(0, 1), cB + hstepB, voffB); PG8_STAGE(PG8_SA(0, 0), cA, voffA); PG8_STAGE(PG8_SA(0, 1), cA + hstepA, voffA);
        if (wr == 1) PG8_BAR;
        PG8_WAIT_V(2); PG8_BAR;
        PG8_STAGE(PG8_SB(1, 0), cB + kstep, voffB); PG8_STAGE(PG8_SA(1, 0), cA + kstep, voffA); PG8_STAGE(PG8_SB(1, 1), cB + hstepB + kstep, voffB);
        PG8_WAIT_V(6); PG8_BAR;
    } else {
        PG8_STAGE(PG8_SB(0, 0), cB, voffB); PG8_STAGE(PG8_SA(0, 0), cA, voffA); PG8_STAGE(PG8_SB(0, 1), cB + hstepB, voffB); PG8_STAGE(PG8_SA(0, 1), cA + hstepA, voffA);
        if (wr == 1) PG8_BAR;
        PG8_WAIT_V(4); PG8_BAR;
        PG8_STAGE(PG8_SB(1, 0), cB + kstep, voffB); PG8_STAGE(PG8_SA(1, 0), cA + kstep, voffA); PG8_STAGE(PG8_SB(1, 1), cB + hstepB + kstep, voffB);
        PG8_WAIT_V(6); PG8_BAR;
    }
    for (;;) {
        const bool has_next = S.next(ui + 1, nxt);
        const char* nA = has_next ? (const char*)g.A + (size_t)nxt.pm * tstepA : cA; const char* nB = has_next ? (const char*)g.Bt + (size_t)nxt.pn * tstepB : cB;
        for (int t = 0; t < nt; t += 2) {
            const bool last = (t == nt - 2);
            const char* a1 = cA + (size_t)(t + 1) * kstep;
            const char* a2 = last ? nA : cA + (size_t)(t + 2) * kstep; const char* b2 = last ? nB : cB + (size_t)(t + 2) * kstep;
            const char* a3 = a2 + kstep; const char* b3 = b2 + kstep;
            if (last && has_next) S.a_ready(nxt);
            if constexpr (SP2) {
            PG8_LDB(B0, 0, 0); PG8_LDB(B1, 0, 1); PG8_SCHED; PG8_LDA(At, 0, 0); PG8_STAGE(PG8_SA(1, 1), a1 + hstepA, voffA);
            PG8_WAIT_V(8); PG8_WAIT_L(0); PG8_BAR; PG8_MMA(0, 0, At, B0); PG8_MMA(0, 1, At, B1); PG8_BAR; PG8_SCHED;
            PG8_LDA(At, 0, 1); PG8_STAGE(PG8_SB(0, 0), b2, voffB); PG8_STAGE(PG8_SB(0, 1), b2 + hstepB, voffB); PG8_STAGE(PG8_SA(0, 0), a2, voffA);
            PG8_WAIT_V(8); PG8_WAIT_L(0); PG8_BAR; PG8_MMA(1, 0, At, B0); PG8_MMA(1, 1, At, B1); PG8_BAR; PG8_SCHED;
            PG8_LDB(B0, 1, 0); PG8_LDB(B1, 1, 1); PG8_SCHED; PG8_LDA(At, 1, 0); PG8_STAGE(PG8_SA(0, 1), a2 + hstepA, voffA);
            PG8_WAIT_V(8); PG8_WAIT_L(0); PG8_BAR; PG8_MMA(0, 0, At, B0); PG8_MMA(0, 1, At, B1); PG8_BAR; PG8_SCHED;
            PG8_LDA(At, 1, 1); PG8_STAGE(PG8_SB(1, 0), b3, voffB); PG8_STAGE(PG8_SB(1, 1), b3 + hstepB, voffB); PG8_STAGE(PG8_SA(1, 0), a3, voffA);
            PG8_WAIT_V(8); PG8_WAIT_L(0); PG8_BAR; PG8_MMA(1, 0, At, B0); PG8_MMA(1, 1, At, B1); PG8_BAR; PG8_SCHED;
            } else {
            PG8_LDB(B0, 0, 0); PG8_SCHED; PG8_LDA(At, 0, 0); PG8_STAGE(PG8_SA(1, 1), a1 + hstepA, voffA);
            PG8_WAIT_L(8); PG8_BAR; PG8_WAIT_L(0); PG8_MMA(0, 0, At, B0); PG8_BAR; PG8_SCHED;
            PG8_LDB(B1, 0, 1); PG8_STAGE(PG8_SB(0, 0), b2, voffB);
            PG8_BAR; PG8_WAIT_L(0); PG8_MMA(0, 1, At, B1); PG8_BAR;
            PG8_LDA(At, 0, 1); PG8_STAGE(PG8_SA(0, 0), a2, voffA);
            PG8_BAR; PG8_WAIT_L(0); PG8_MMA(1, 0, At, B0); PG8_BAR; PG8_SCHED;
            PG8_STAGE(PG8_SB(0, 1), b2 + hstepB, voffB);
            PG8_WAIT_V(6); PG8_BAR; PG8_MMA(1, 1, At, B1); PG8_BAR;
            PG8_LDB(B0, 1, 0); PG8_SCHED; PG8_LDA(At, 1, 0); PG8_STAGE(PG8_SA(0, 1), a2 + hstepA, voffA);
            PG8_WAIT_L(8); PG8_BAR; PG8_WAIT_L(0); PG8_MMA(0, 0, At, B0); PG8_BAR; PG8_SCHED;
            PG8_LDB(B1, 1, 1); PG8_STAGE(PG8_SB(1, 0), b3, voffB);
            PG8_BAR; PG8_WAIT_L(0); PG8_MMA(0, 1, At, B1); PG8_BAR;
            PG8_LDA(At, 1, 1); PG8_STAGE(PG8_SA(1, 0), a3, voffA);
            PG8_BAR; PG8_WAIT_L(0); PG8_MMA(1, 0, At, B0); PG8_BAR; PG8_SCHED;
            PG8_STAGE(PG8_SB(1, 1), b3 + hstepB, voffB);
            PG8_WAIT_V(6); PG8_BAR; PG8_MMA(1, 1, At, B1); PG8_BAR;
            }
        }
        if constexpr (ALIGN_EPI) { if (wr == 0) PG8_BAR; }
        if constexpr (!Epi::AFTER_DRAIN) { E(acc, cur, wr, wc, fr, fq); S.done(cur); }
        if (!has_next) break;
#pragma unroll
        for (int a = 0; a < 2; ++a)
#pragma unroll
            for (int b = 0; b < 2; ++b)
#pragma unroll
                for (int m = 0; m < 4; ++m)
#pragma unroll
                    for (int n = 0; n < 2; ++n) acc[a][b][m][n] = (f32x4){0.f, 0.f, 0.f, 0.f};
        cur = nxt; cA = nA; cB = nB; ++ui;
        if constexpr (ALIGN_EPI) { if (wr == 1) PG8_BAR; }
    }
    PG8_WAIT_V(0);
    if constexpr (!ALIGN_EPI) { if (wr == 0) PG8_BAR; }
    PG8_BAR;
    if constexpr (Epi::AFTER_DRAIN) { E.fused(acc, cur, wr, wc, fr, fq, lds, wid, lane); S.done(cur); }
#undef PG8_SA
#undef PG8_SB
#undef PG8_STAGE
#undef PG8_LDA
#undef PG8_LDB
#undef PG8_MMA
#undef PG8_WAIT_V
#undef PG8_WAIT_L
#undef PG8_BAR
#undef PG8_SCHED
}
}

namespace pg8 {
typedef unsigned u32x2 __attribute__((ext_vector_type(2)));
constexpr float RMS_EPS = 1e-6f;
__device__ __forceinline__ float dot4(const f32x4 a) { return (a[0] * a[0] + a[1] * a[1]) + (a[2] * a[2] + a[3] * a[3]); }
__device__ __forceinline__ float rowsum32(const float* ssp, int row, int nsl4, int fq) {
    f32x4 v = {0.f, 0.f, 0.f, 0.f};
    if (fq < nsl4) v = *(const f32x4*)(ssp + (size_t)row * 32 + 4 * fq);
    if (fq + 4 < nsl4) v = v + *(const f32x4*)(ssp + (size_t)row * 32 + 4 * (fq + 4));
    float s = (v[0] + v[1]) + (v[2] + v[3]);
    s += __shfl_xor(s, 16); s += __shfl_xor(s, 32);
    return s;
}

struct EpiBf {
    static constexpr bool PERM = true, AFTER_DRAIN = false;
    bf16_t* O; int ldc;
    const float* ss; float inv_w; int nsl4;
    int nscale; float scale;
    float* ssA; int a_lo, a_hi; float* ssB; int b_lo, b_hi;
    int rope_lo; bf16_t* R; int ldr; int rmode;
    const float* cs; const float* sn;
    PG8_LAS float* tab; mutable int last_pm;
    __device__ __forceinline__ void operator()(const f32x4 (&acc)[2][2][4][2], const Unit& u, int wr, int wc, int fr, int fq) const {
        const int row0 = u.pm * BM + wr * 64 + fr;
        const float sc = (u.pn < nscale) ? scale : 1.f;
        float* sacc = nullptr; int slot0 = 0;
        if (u.pn >= a_lo && u.pn < a_hi) { sacc = ssA; slot0 = (u.pn - a_lo) * 4 + wc; } else if (u.pn >= b_lo && u.pn < b_hi) { sacc = ssB; slot0 = (u.pn - b_lo) * 4 + wc; }
        float rs[2][4];
        if (!ss) {
#pragma unroll
            for (int ai = 0; ai < 2; ++ai)
#pragma unroll
                for (int m = 0; m < 4; ++m) rs[ai][m] = sc;
        } else if (u.pm != last_pm) {
#pragma unroll
            for (int ai = 0; ai < 2; ++ai)
#pragma unroll
                for (int m = 0; m < 4; ++m) { const int row = row0 + ai * HALF + m * 16; const float r_ = __builtin_amdgcn_rsqf(rowsum32(ss, row, nsl4, fq) * inv_w + RMS_EPS);
                    tab[ai * HALF + wr * 64 + m * 16 + fr] = r_; rs[ai][m] = r_ * sc; }
            last_pm = u.pm;
        } else {
#pragma unroll
            for (int ai = 0; ai < 2; ++ai)
#pragma unroll
                for (int m = 0; m < 4; ++m) rs[ai][m] = tab[ai * HALF + wr * 64 + m * 16 + fr] * sc;
        }
        if (u.pn >= rope_lo) {
            const int t = u.pn - rope_lo;
#pragma unroll
            for (int ai = 0; ai < 2; ++ai)
#pragma unroll
            for (int mh = 0; mh < 2; ++mh) {
                f32x4 cc[2][2], sv[2][2];
#pragma unroll
                for (int mm = 0; mm < 2; ++mm) { const size_t ro = (size_t)(row0 + ai * HALF + (2 * mh + mm) * 16) * 32 + 8 * fq;
                    cc[mm][0] = *(const f32x4*)(cs + ro); cc[mm][1] = *(const f32x4*)(cs + ro + 4); sv[mm][0] = *(const f32x4*)(sn + ro); sv[mm][1] = *(const f32x4*)(sn + ro + 4); }
#pragma unroll
                for (int mm = 0; mm < 2; ++mm) {
                    const int m = 2 * mh + mm;
                    const int row = row0 + ai * HALF + m * 16; const float r_ = rs[ai][m];
                    const f32x4 c0 = cc[mm][0], c1 = cc[mm][1], s0 = sv[mm][0], s1 = sv[mm][1];
                    const f32x4 x10 = acc[ai][0][m][0] * r_, x11 = acc[ai][0][m][1] * r_, x20 = acc[ai][1][m][0] * r_, x21 = acc[ai][1][m][1] * r_;
                    const f32x4 o10 = x10 * c0 - x20 * s0, o11 = x11 * c1 - x21 * s1, o20 = x10 * s0 + x20 * c0, o21 = x11 * s1 + x21 * c1;
                    u32x4 w1, w2;
                    w1.x = cvt_pk_bf16(o10[0], o10[1]); w1.y = cvt_pk_bf16(o10[2], o10[3]); w1.z = cvt_pk_bf16(o11[0], o11[1]); w1.w = cvt_pk_bf16(o11[2], o11[3]);
                    w2.x = cvt_pk_bf16(o20[0], o20[1]); w2.y = cvt_pk_bf16(o20[2], o20[3]); w2.z = cvt_pk_bf16(o21[0], o21[1]); w2.w = cvt_pk_bf16(o21[2], o21[3]);
                    if (rmode == 0) { if (wc == 0) { bf16_t* p = R + (size_t)row * 64 + 8 * fq; *(u32x4*)p = w1; *(u32x4*)(p + 32) = w2; } }
                    else { bf16_t* p = R + (size_t)row * ldr + (4 * t + wc) * 64 + 8 * fq; *(u32x4*)p = w1; *(u32x4*)(p + 32) = w2; }
                }
            }
            return;
        }
#pragma unroll
        for (int ai = 0; ai < 2; ++ai)
#pragma unroll
            for (int m = 0; m < 4; ++m) {
                const int row = row0 + ai * HALF + m * 16;
                const float r_ = rs[ai][m];
                bf16_t* rowp = O + (size_t)row * ldc + u.pn * BM + wc * 32 + 8 * fq;
                float q = 0.f;
#pragma unroll
                for (int bj = 0; bj < 2; ++bj) {
                    const f32x4 v0 = acc[ai][bj][m][0] * r_, v1 = acc[ai][bj][m][1] * r_;
                    q += dot4(v0) + dot4(v1);
                    u32x4 w; w.x = cvt_pk_bf16(v0[0], v0[1]); w.y = cvt_pk_bf16(v0[2], v0[3]); w.z = cvt_pk_bf16(v1[0], v1[1]); w.w = cvt_pk_bf16(v1[2], v1[3]);
                    *(u32x4*)(rowp + bj * HALF) = w;
                }
                if (sacc) { q += __shfl_xor(q, 16); q += __shfl_xor(q, 32); if (fq == 0) sacc[(size_t)row * 32 + slot0] = q; }
            }
    }
};

typedef _Float16 f16x8v __attribute__((ext_vector_type(8)));
typedef float f32x8v __attribute__((ext_vector_type(8)));
struct EpiRes {
    static constexpr bool PERM = true, AFTER_DRAIN = false;
    const float* base32; _Float16* xh; float* ssn; int ldc; int pf;
    __device__ __forceinline__ void operator()(const f32x4 (&acc)[2][2][4][2], const Unit& u, int wr, int wc, int fr, int fq) const {
        const int row0 = u.pm * BM + wr * 64 + fr, col0 = u.pn * BM + wc * 32 + 8 * fq;
#pragma unroll
        for (int ai = 0; ai < 2; ++ai)
#pragma unroll
        for (int mh = 0; mh < 2; ++mh) {
            f32x8v pre[2][2];
            if (base32) {
#pragma unroll
                for (int mm = 0; mm < 2; ++mm) { const size_t off = (size_t)(row0 + ai * HALF + (2 * mh + mm) * 16) * ldc + col0;
#pragma unroll
                    for (int bj = 0; bj < 2; ++bj) { const f32x4 a0 = *(const f32x4*)(base32 + off + bj * HALF), a1 = *(const f32x4*)(base32 + off + bj * HALF + 4);
                        pre[mm][bj] = __builtin_shufflevector(a0, a1, 0, 1, 2, 3, 4, 5, 6, 7); } }
            } else if (pf & 1) {
#pragma unroll
                for (int mm = 0; mm < 2; ++mm)
#pragma unroll
                    for (int bj = 0; bj < 2; ++bj) pre[mm][bj] = (f32x8v){0, 0, 0, 0, 0, 0, 0, 0};
            } else {
                f16x8v ph[2][2];
#pragma unroll
                for (int mm = 0; mm < 2; ++mm) { const size_t off = (size_t)(row0 + ai * HALF + (2 * mh + mm) * 16) * ldc + col0;
#pragma unroll
                    for (int bj = 0; bj < 2; ++bj) ph[mm][bj] = *(const f16x8v*)(xh + off + bj * HALF); }
#pragma unroll
                for (int mm = 0; mm < 2; ++mm)
#pragma unroll
                    for (int bj = 0; bj < 2; ++bj) pre[mm][bj] = __builtin_convertvector(ph[mm][bj], f32x8v);
            }
#pragma unroll
            for (int mm = 0; mm < 2; ++mm) {
                const int m = 2 * mh + mm;
                const int row = row0 + ai * HALF + m * 16; const size_t off = (size_t)row * ldc + col0;
                float q = 0.f;
#pragma unroll
                for (int bj = 0; bj < 2; ++bj) {
                    const f32x8v o = pre[mm][bj] + __builtin_shufflevector(acc[ai][bj][m][0], acc[ai][bj][m][1], 0, 1, 2, 3, 4, 5, 6, 7);
                    if (!(pf & 2)) *(f16x8v*)(xh + off + bj * HALF) = __builtin_convertvector(o, f16x8v);
                    q += ((o[0] * o[0] + o[1] * o[1]) + (o[2] * o[2] + o[3] * o[3])) + ((o[4] * o[4] + o[5] * o[5]) + (o[6] * o[6] + o[7] * o[7]));
                }
                if (!(pf & 4)) { q += __shfl_xor(q, 16); q += __shfl_xor(q, 32);
                if (fq == 0) ssn[(size_t)row * 32 + u.pn * 4 + wc] = q; }
                else if (pf & 2) { if (q == 12345.678f) ssn[0] = q; }
            }
        }
    }
};

struct EpiGU {
    static constexpr bool PERM = true, AFTER_DRAIN = false;
    bf16_t* H; int ldc; const float* ss; float inv_w; PG8_LAS float* tab; mutable int last_pm;
    __device__ __forceinline__ void operator()(const f32x4 (&acc)[2][2][4][2], const Unit& u, int wr, int wc, int fr, int fq) const {
        const int row0 = u.pm * BM + wr * 64 + fr;
        float rsa[2][4];
        if (u.pm != last_pm) {
#pragma unroll
            for (int ai = 0; ai < 2; ++ai)
#pragma unroll
                for (int m = 0; m < 4; ++m) { rsa[ai][m] = __builtin_amdgcn_rsqf(rowsum32(ss, row0 + ai * HALF + m * 16, 8, fq) * inv_w + RMS_EPS); tab[ai * HALF + wr * 64 + m * 16 + fr] = rsa[ai][m]; }
            last_pm = u.pm;
        } else {
#pragma unroll
            for (int ai = 0; ai < 2; ++ai)
#pragma unroll
                for (int m = 0; m < 4; ++m) rsa[ai][m] = tab[ai * HALF + wr * 64 + m * 16 + fr];
        }
#pragma unroll
        for (int ai = 0; ai < 2; ++ai)
#pragma unroll
            for (int m = 0; m < 4; ++m) {
                const int row = row0 + ai * HALF + m * 16;
                const float rs = rsa[ai][m];
                float h[8];
#pragma unroll
                for (int n = 0; n < 2; ++n)
#pragma unroll
                    for (int e = 0; e < 4; ++e) {
                        const float g = acc[ai][0][m][n][e] * rs, uu = acc[ai][1][m][n][e] * rs;
                        const float sg = __builtin_amdgcn_rcpf(1.f + __builtin_amdgcn_exp2f(g * -1.4426950408889634f));
                        h[n * 4 + e] = g * sg * uu;
                    }
                u32x4 w; w.x = cvt_pk_bf16(h[0], h[1]); w.y = cvt_pk_bf16(h[2], h[3]); w.z = cvt_pk_bf16(h[4], h[5]); w.w = cvt_pk_bf16(h[6], h[7]);
                *(u32x4*)(H + (size_t)row * ldc + u.pn * HALF + wc * 32 + 8 * fq) = w;
            }
    }
};
}

namespace att {
typedef unsigned short bf16_t;
using bf16x8 = __attribute__((ext_vector_type(8))) short;
using s16x4  = __attribute__((ext_vector_type(4))) short;
using f32x16 = __attribute__((ext_vector_type(16))) float;
using u32x4  = __attribute__((ext_vector_type(4))) unsigned;
constexpr int NW = 8, QBLK = 32, KVBLK = 64;
constexpr int SHM_V = 16384, SHM_K = 16384, SHM_K2 = 8192;
constexpr int OFF_V = 0, OFF_K = 2 * SHM_V, OFF_WS = OFF_K + 2 * SHM_K, OFF_TB = OFF_WS + NW * 64 * 4, OFF_AUX = OFF_TB + 2048;
constexpr int OFF_K2 = OFF_AUX, OFF_Q2 = OFF_K2 + 2 * SHM_K2  , OFF_Q1 = OFF_AUX  , OFF_QH = OFF_Q2 + NW * 4096  , OFF_Q3 = OFF_QH + NW * 4096  , ATT_LDS = OFF_Q3 + NW * 1024;
constexpr int SDEPTH = 1;
constexpr float THR = 8.f;
#define KSWZ(row, colB) ((row) * 256 + ((colB) ^ (((row) & 7) << 4)))
#define K2SWZ(row, colB) ((row) * 128 + ((colB) ^ ((((row) >> 1) & 7) << 4)))
#define SBAR() __builtin_amdgcn_sched_barrier(0)
__device__ __forceinline__ int crow(int r, int hi) { return (r & 3) + 8 * (r >> 2) + 4 * hi; }
typedef float f32x2_t __attribute__((ext_vector_type(2)));
typedef __bf16 bf16x2_t __attribute__((ext_vector_type(2)));
__device__ __forceinline__ unsigned cvtpk(float lo, float hi) { f32x2_t v = {lo, hi}; bf16x2_t b = __builtin_convertvector(v, bf16x2_t); return __builtin_bit_cast(unsigned, b); }

__device__ __forceinline__ void partialSM(f32x16& p0, f32x16& p1, float& m_reg, float& mn, float& alpha) {
  float pmax = p0[0];
#pragma unroll
  for (int r = 1; r < 16; ++r) pmax = fmaxf(pmax, p0[r]);
#pragma unroll
  for (int r = 0; r < 16; ++r) pmax = fmaxf(pmax, p1[r]);
  { auto rr = __builtin_amdgcn_permlane32_swap(__float_as_uint(pmax), __float_as_uint(pmax), false, false);
    pmax = fmaxf(__uint_as_float(rr[0]), __uint_as_float(rr[1])); }
  if (__builtin_expect(__all(pmax - m_reg <= THR), 1)) { mn = m_reg; alpha = 1.f; }
  else { mn = fmaxf(m_reg, pmax); alpha = __builtin_amdgcn_exp2f(m_reg - mn); m_reg = mn; }
#pragma unroll
  for (int r = 0; r < 16; ++r) p0[r] = p0[r] - mn;
#pragma unroll
  for (int r = 0; r < 16; ++r) p1[r] = p1[r] - mn;
#pragma unroll
  for (int r = 0; r < 16; ++r) p0[r] = __builtin_amdgcn_exp2f(p0[r]);
}
__device__ __forceinline__ void finishSM(f32x16& p0, f32x16& p1, float alpha, float& l_reg, bf16x8& pa0, bf16x8& pa1, bf16x8& pa2, bf16x8& pa3) {
#pragma unroll
  for (int r = 0; r < 16; ++r) p1[r] = __builtin_amdgcn_exp2f(p1[r]);
  float ps = 0;
#pragma unroll
  for (int r = 0; r < 16; ++r) ps += p0[r];
#pragma unroll
  for (int r = 0; r < 16; ++r) ps += p1[r];
  { auto rr = __builtin_amdgcn_permlane32_swap(__float_as_uint(ps), __float_as_uint(ps), false, false);
    ps = __uint_as_float(rr[0]) + __uint_as_float(rr[1]); }
  l_reg = l_reg * alpha + ps;
#define PK4(P, BASE, OUT) do { unsigned a0 = cvtpk(P[BASE + 0], P[BASE + 1]), a1 = cvtpk(P[BASE + 2], P[BASE + 3]);   \
    unsigned b0 = cvtpk(P[BASE + 4], P[BASE + 5]), b1 = cvtpk(P[BASE + 6], P[BASE + 7]);                              \
    auto r0 = __builtin_amdgcn_permlane32_swap(a0, b0, false, false); auto r1 = __builtin_amdgcn_permlane32_swap(a1, b1, false, false); \
    u32x4 w = {r0[0], r1[0], r0[1], r1[1]}; OUT = *reinterpret_cast<bf16x8*>(&w); } while (0)
  PK4(p0, 0, pa0); PK4(p0, 8, pa1); PK4(p1, 0, pa2); PK4(p1, 8, pa3);
#undef PK4
}
#define KFRAG(d, hf) (((d) < 8) ? *reinterpret_cast<const bf16x8*>(Ks + KSWZ((hf) * 32 + r32, ((d) * 16 + hi * 8) * 2)) \
                                : *reinterpret_cast<const bf16x8*>(K2s + K2SWZ((hf) * 32 + r32, (((d) - 8) * 16 + hi * 8) * 2)))
#define QLDS(d) (((d) == 3) ? *reinterpret_cast<const bf16x8*>(Q3s) : ((d) < 8) ? *reinterpret_cast<const bf16x8*>(QHs + K2SWZ(r32, (((d) - 4) * 16 + hi * 8) * 2)) \
                           : *reinterpret_cast<const bf16x8*>(Q2s + K2SWZ(r32, (((d) - 8) * 16 + hi * 8) * 2)))
template <int MODE>
__device__ __forceinline__ void qkt(f32x16& p0, f32x16& p1, const char* Ks, const char* K2s, const bf16x8* qr, const char* Q2s, const char* QHs, const char* Q3s, int r32, int hi, bool valid) {
  if constexpr (MODE == 1) {
    if (!valid) {
#pragma unroll
      for (int r = 0; r < 16; ++r) { p0[r] = -INFINITY; p1[r] = -INFINITY; }
      return; }
    p0 = f32x16{}; p1 = f32x16{};
#pragma unroll
    for (int d0 = 0; d0 < 8; ++d0) { const int cb = (d0 * 16 + hi * 8) * 2;
      bf16x8 b0 = *reinterpret_cast<const bf16x8*>(Ks + KSWZ(r32, cb));
      bf16x8 b1 = *reinterpret_cast<const bf16x8*>(Ks + KSWZ(32 + r32, cb));
      bf16x8 qf = *reinterpret_cast<const bf16x8*>(Q2s + KSWZ(r32, cb));
      p0 = __builtin_amdgcn_mfma_f32_32x32x16_bf16(b0, qf, p0, 0, 0, 0);
      p1 = __builtin_amdgcn_mfma_f32_32x32x16_bf16(b1, qf, p1, 0, 0, 0); }
  } else {
    p0 = f32x16{}; p1 = f32x16{};
    constexpr int ND = (MODE == 2) ? 12 : 8;
    bf16x8 ka[2], kb[2];
    ka[0] = KFRAG(0, 0); kb[0] = KFRAG(0, 1);
#pragma unroll
    for (int d = 0; d < ND; ++d) {
      bf16x8 q; if (MODE == 2 && d >= 3) q = QLDS(d); else q = qr[d < 8 ? d : 0];
      if (d + 1 < ND) { ka[(d + 1) & 1] = KFRAG(d + 1, 0); kb[(d + 1) & 1] = KFRAG(d + 1, 1); }
      p0 = __builtin_amdgcn_mfma_f32_32x32x16_bf16(ka[d & 1], q, p0, 0, 0, 0);
      p1 = __builtin_amdgcn_mfma_f32_32x32x16_bf16(kb[d & 1], q, p1, 0, 0, 0);
    }
    __builtin_amdgcn_sched_group_barrier(0x100, 2, 0);
#pragma unroll
    for (int d = 0; d < ND; ++d) {
      { const int nrd = ((MODE == 2 && d >= 3) ? 1 : 0) + ((d + 1 < ND) ? 2 : 0);
        if (nrd == 3) __builtin_amdgcn_sched_group_barrier(0x100, 3, 0); else if (nrd == 2) __builtin_amdgcn_sched_group_barrier(0x100, 2, 0); else if (nrd == 1) __builtin_amdgcn_sched_group_barrier(0x100, 1, 0); }
      __builtin_amdgcn_sched_group_barrier(0x008, 2, 0);
    }
    if constexpr (MODE == 2) {
      const float msk = valid ? 0.f : -INFINITY;
#pragma unroll
      for (int r = 0; r < 16; ++r) { p0[r] = valid ? p0[r] : msk; p1[r] = valid ? p1[r] : msk; }
    }
  }
}
#undef KFRAG
#undef QLDS
__device__ __forceinline__ void add_bias(f32x16& p0, f32x16& p1, const float* tb, int rel0, bool far) {
  if (far) { const float c = tb[256];
#pragma unroll
    for (int r = 0; r < 16; ++r) { p0[r] += c; p1[r] += c; }
  } else {
#pragma unroll
    for (int r = 0; r < 16; ++r) { const int kk = (r & 3) + 8 * (r >> 2);
      int i0 = rel0 - kk; i0 = i0 > 128 ? 128 : i0;
      int i1 = rel0 - 32 - kk; i1 = i1 > 128 ? 128 : i1;
      p0[r] += tb[i0 + 128]; p1[r] += tb[i1 + 128];
      if ((r & 1) == 1) SBAR(); }
  }
}
__device__ __forceinline__ int v_st(int k, int c) { const int kk = (k & ~0xC) | ((k & 4) << 1) | ((k & 8) >> 1); return ((kk >> 3) * 4 + (c >> 5)) * 512 + ((kk & 7) * 32 + (c & 31)) * 2; }
__device__ __forceinline__ int v_rd_base(int lane) { return ((lane & 3) << 3) | (((lane >> 2) & 3) << 6) | (((lane >> 4) & 1) << 5) | (((lane >> 5) & 1) << 8); }
constexpr int v_rd_off(int d0, int ks, int half) { return d0 * 512 + ks * 4096 + half * 2048; }
template <int OFF> __device__ __forceinline__ s16x4 tr_read(int vb) {
  s16x4 r; asm volatile("ds_read_b64_tr_b16 %0, %1 offset:%2" : "=&v"(r) : "v"(vb), "i"(OFF) : "memory"); return r;
}
template <int D0> __device__ __forceinline__ void pv_one(f32x16& od, int vb, bf16x8 pa0, bf16x8 pa1, bf16x8 pa2, bf16x8 pa3) {
  const s16x4 l0 = tr_read<v_rd_off(D0, 0, 0)>(vb), h0 = tr_read<v_rd_off(D0, 0, 1)>(vb), l1 = tr_read<v_rd_off(D0, 1, 0)>(vb), h1 = tr_read<v_rd_off(D0, 1, 1)>(vb);
  const s16x4 l2 = tr_read<v_rd_off(D0, 2, 0)>(vb), h2 = tr_read<v_rd_off(D0, 2, 1)>(vb), l3 = tr_read<v_rd_off(D0, 3, 0)>(vb), h3 = tr_read<v_rd_off(D0, 3, 1)>(vb);
  asm volatile("s_waitcnt lgkmcnt(0)" ::: "memory"); SBAR();
#define PK(L, H) (bf16x8){L[0], L[1], L[2], L[3], H[0], H[1], H[2], H[3]}
  od = __builtin_amdgcn_mfma_f32_32x32x16_bf16(pa0, PK(l0, h0), od, 0, 0, 0);
  od = __builtin_amdgcn_mfma_f32_32x32x16_bf16(pa1, PK(l1, h1), od, 0, 0, 0);
  od = __builtin_amdgcn_mfma_f32_32x32x16_bf16(pa2, PK(l2, h2), od, 0, 0, 0);
  od = __builtin_amdgcn_mfma_f32_32x32x16_bf16(pa3, PK(l3, h3), od, 0, 0, 0);
#undef PK
}
__device__ __forceinline__ void pv_d0(f32x16* o, int vb, bf16x8 pa0, bf16x8 pa1, bf16x8 pa2, bf16x8 pa3) {
  pv_one<0>(o[0], vb, pa0, pa1, pa2, pa3); pv_one<1>(o[1], vb, pa0, pa1, pa2, pa3); pv_one<2>(o[2], vb, pa0, pa1, pa2, pa3); pv_one<3>(o[3], vb, pa0, pa1, pa2, pa3);
}

template <int MODE>
__device__ __forceinline__ void attn_unit(char* lds, const bf16_t* __restrict__ Qb, const bf16_t* __restrict__ Q2b, const bf16_t* __restrict__ Kh, const bf16_t* __restrict__ Vh,
                                          const bf16_t* __restrict__ K2h, bf16_t* __restrict__ Ob, int ldq, int ldq2, int ldk, int ldo, int NT, int qc0, int kc0, const float* __restrict__ bias_g) {
  int tid = threadIdx.x; asm volatile("" : "+v"(tid));
  const int wid = __builtin_amdgcn_readfirstlane(tid >> 6), lane = tid & 63, r32 = lane & 31, hi = lane >> 5;
  char* V_lds = lds + OFF_V; char* K_lds = lds + OFF_K; char* K2_lds = lds + OFF_K2;
  float* ws = (float*)(lds + OFF_WS) + wid * 64; float* li_l = ws; float* al_l = ws + 32;
  float* tb = (float*)(lds + OFF_TB);
  int jlo = 0, jhi = NT - 1;
  if constexpr (MODE == 1) { const int cq = qc0 + (wid >> 1); jlo = (cq - 8 > 0 ? cq - 8 : 0) - kc0; jhi = cq - kc0; }
  if constexpr (MODE == 2) { jhi = qc0 + (wid >> 1) - kc0; }
  if constexpr (MODE == 1) { if (tid < 257) tb[tid] = bias_g[tid] * 1.4426950408889634f; }
  float m_reg = -1e30f, l_reg = 0; f32x16 o[4] = {}; bf16x8 qr[8];
  char* Q2s = (MODE == 1) ? lds + OFF_Q1 + wid * 8192 : lds + OFF_Q2 + wid * 4096;
  char* QHs = lds + OFF_QH + wid * 4096; char* Q3s = lds + OFF_Q3 + wid * 1024 + lane * 16;
  const bf16_t* Qw = Qb + (long)(wid * QBLK + r32) * ldq + hi * 8;
  if constexpr (MODE == 1) {
#pragma unroll
    for (int d0 = 0; d0 < 8; ++d0) *reinterpret_cast<bf16x8*>(Q2s + KSWZ(r32, (d0 * 16 + hi * 8) * 2)) = *reinterpret_cast<const bf16x8*>(Qw + d0 * 16);
    asm volatile("s_waitcnt lgkmcnt(0)" ::: "memory");
  } else if constexpr (MODE == 2) {
#pragma unroll
    for (int d0 = 0; d0 < 3; ++d0) qr[d0] = *reinterpret_cast<const bf16x8*>(Qw + d0 * 16);
    *reinterpret_cast<bf16x8*>(Q3s) = *reinterpret_cast<const bf16x8*>(Qw + 3 * 16);
#pragma unroll
    for (int d0 = 4; d0 < 8; ++d0) *reinterpret_cast<bf16x8*>(QHs + K2SWZ(r32, ((d0 - 4) * 16 + hi * 8) * 2)) = *reinterpret_cast<const bf16x8*>(Qw + d0 * 16);
    asm volatile("s_waitcnt lgkmcnt(0)" ::: "memory");
  } else {
#pragma unroll
    for (int d0 = 0; d0 < 8; ++d0) qr[d0] = *reinterpret_cast<const bf16x8*>(Qw + d0 * 16);
  }
  if constexpr (MODE == 2) { const bf16_t* Q2w = Q2b + (long)(wid * QBLK + r32) * ldq2 + hi * 8;
#pragma unroll
    for (int d0 = 0; d0 < 4; ++d0) *reinterpret_cast<bf16x8*>(Q2s + K2SWZ(r32, (d0 * 16 + hi * 8) * 2)) = *reinterpret_cast<const bf16x8*>(Q2w + d0 * 16);
    asm volatile("s_waitcnt lgkmcnt(0)" ::: "memory"); }
  const int sr = tid >> 4, sc = (tid & 15) * 8, vst0 = v_st(sr, sc), vst1 = v_st(32 + sr, sc);
  const int s2r = tid >> 3, s2c = (tid & 7) * 8;
  const int vb0 = (int)(uintptr_t)V_lds + v_rd_base(lane);
  const int relq = (qc0 - kc0) * 64 + wid * 32 + r32 - 4 * hi;
  struct { bf16x8 vs0, vs1, ks0, ks1, k2; } sr_[SDEPTH];
#define SLOAD(i, jt) do { const long k0_ = (long)(jt) * KVBLK; sr_[i].vs0 = *reinterpret_cast<const bf16x8*>(&Vh[(k0_ + sr) * ldk + sc]); sr_[i].vs1 = *reinterpret_cast<const bf16x8*>(&Vh[(k0_ + 32 + sr) * ldk + sc]); \
    sr_[i].ks0 = *reinterpret_cast<const bf16x8*>(&Kh[(k0_ + sr) * ldk + sc]); sr_[i].ks1 = *reinterpret_cast<const bf16x8*>(&Kh[(k0_ + 32 + sr) * ldk + sc]); \
    if constexpr (MODE == 2) sr_[i].k2 = *reinterpret_cast<const bf16x8*>(&K2h[(k0_ + s2r) * 64 + s2c]); } while (0)
#define SWRITE(b, i) do { *(bf16x8*)(V_lds + (b) * SHM_V + vst0) = sr_[i].vs0;          \
    *(bf16x8*)(V_lds + (b) * SHM_V + vst1) = sr_[i].vs1; const int kc_ = sc * 2;               \
    *(bf16x8*)(K_lds + (b) * SHM_K + KSWZ(sr, kc_)) = sr_[i].ks0;                       \
    *(bf16x8*)(K_lds + (b) * SHM_K + KSWZ(32 + sr, kc_)) = sr_[i].ks1; \
    if constexpr (MODE == 2) *(bf16x8*)(K2_lds + (b) * SHM_K2 + K2SWZ(s2r, s2c * 2)) = sr_[i].k2; } while (0)
#define SWAIT() do { if constexpr (SDEPTH == 1) asm volatile("s_waitcnt vmcnt(0)" ::: "memory"); else if constexpr (MODE == 2) asm volatile("s_waitcnt vmcnt(5)" ::: "memory"); else asm volatile("s_waitcnt vmcnt(4)" ::: "memory"); } while (0)
#define RESC(a) do { if (__any((a) < 1.f)) { if (hi == 0) al_l[r32] = (a); asm volatile("s_waitcnt lgkmcnt(0)" ::: "memory"); \
    _Pragma("unroll") for (int d = 0; d < 4; ++d) _Pragma("unroll") for (int r = 0; r < 16; ++r) o[d][r] *= al_l[crow(r, hi)]; } } while (0)
#define VALID(j) ((j) >= jlo && (j) <= jhi)
#define QKT(P0, P1, b, j) do { const bool v_ = VALID(j); qkt<MODE>(P0, P1, K_lds + (b) * SHM_K, K2_lds + (b) * SHM_K2, qr, Q2s, QHs, Q3s, r32, hi, v_); \
    if constexpr (MODE == 1) { if (v_) { const bool far_ = ((qc0 - kc0) * 64 + wid * 32 - (j) * 64 - 63) >= 128; add_bias(P0, P1, tb, relq - (j) * 64, far_); } } } while (0)
  f32x16 pA0, pA1, pB0, pB1; float mnA, mnB, alA, alB; bf16x8 pa0, pa1, pa2, pa3;
  constexpr int SE = 0, SO = SDEPTH - 1;
  SLOAD(SE, 0); asm volatile("s_waitcnt vmcnt(0)" ::: "memory"); SWRITE(0, SE); __syncthreads();
  QKT(pA0, pA1, 0, 0); partialSM(pA0, pA1, m_reg, mnA, alA);
  SLOAD(SO, 1); if constexpr (SDEPTH == 2) { if (2 < NT) SLOAD(SE, 2); }
  SWAIT(); SWRITE(1, SO); __syncthreads();
  for (int j = 1; j + 1 < NT; j += 2) {
    SBAR(); QKT(pB0, pB1, 1, j);
    finishSM(pA0, pA1, alA, l_reg, pa0, pa1, pa2, pa3); SBAR();
    SLOAD(SO, j + SDEPTH); SBAR();
    if (MODE != 1 || VALID(j - 1)) pv_d0(o, vb0, pa0, pa1, pa2, pa3);
    partialSM(pB0, pB1, m_reg, mnB, alB);
    __syncthreads(); SWAIT(); SWRITE(0, SE);
    RESC(alB); __syncthreads();
    SBAR(); QKT(pA0, pA1, 0, j + 1);
    finishSM(pB0, pB1, alB, l_reg, pa0, pa1, pa2, pa3); SBAR();
    if (SDEPTH == 1 || j + 3 < NT) SLOAD(SE, j + 1 + SDEPTH); SBAR();
    if (MODE != 1 || VALID(j)) pv_d0(o, vb0 + SHM_V, pa0, pa1, pa2, pa3);
    partialSM(pA0, pA1, m_reg, mnA, alA);
    __syncthreads(); SWAIT(); SWRITE(1, SO);
    RESC(alA); __syncthreads();
  }
  SBAR(); QKT(pB0, pB1, 1, NT - 1);
  finishSM(pA0, pA1, alA, l_reg, pa0, pa1, pa2, pa3); SBAR();
  if (MODE != 1 || VALID(NT - 2)) pv_d0(o, vb0, pa0, pa1, pa2, pa3);
  partialSM(pB0, pB1, m_reg, mnB, alB);
  __syncthreads(); RESC(alB);
  finishSM(pB0, pB1, alB, l_reg, pa0, pa1, pa2, pa3); SBAR();
  if (MODE != 1 || VALID(NT - 1)) pv_d0(o, vb0 + SHM_V, pa0, pa1, pa2, pa3);
  if (hi == 0) li_l[r32] = l_reg; asm volatile("s_waitcnt lgkmcnt(0)" ::: "memory");
  float rli[16];
#pragma unroll
  for (int r = 0; r < 16; ++r) rli[r] = __builtin_amdgcn_rcpf(li_l[crow(r, hi)]);
  bf16_t* Ow = Ob + (long)(wid * QBLK) * ldo;
#pragma unroll
  for (int r = 0; r < 16; ++r) { const int orow = crow(r, hi);
#pragma unroll
    for (int d0 = 0; d0 < 4; ++d0) Ow[(long)orow * ldo + d0 * 32 + r32] = (bf16_t)(cvtpk(o[d0][r] * rli[r], 0.f) & 0xffffu); }
  __syncthreads();
#undef SLOAD
#undef SWRITE
#undef SWAIT
#undef RESC
#undef VALID
#undef QKT
}
}

#define LAS __attribute__((address_space(3)))
typedef unsigned short bf16;
typedef unsigned v4u __attribute__((ext_vector_type(4)));
typedef float f32x4 __attribute__((ext_vector_type(4)));

constexpr int BATCH = 4, SEQ = 4096, M = BATCH * SEQ, DM = 2048, DEPTH = 4;
constexpr int INW = 4416, INP = 4608, QW = 1536, KVW = 2048, DFF = 5632, NMEM = 256, XW = 512;
constexpr float EPS = 1e-6f, LOG2E = 1.4426950408889634f;
constexpr size_t MiB = 1u << 20;
constexpr size_t WS_COS = 2 * MiB, WS_SIN = 4 * MiB, WS_MEMN = 6 * MiB, WS_MEMKV = 10 * MiB, WS_KR = 18 * MiB, WS_WXKV = 20 * MiB;
constexpr size_t WS_W = 36 * MiB, W_LAYER = 101 * MiB;
constexpr size_t WO_IN = 0, WO_UQ = 18 * MiB, WO_UKV = 21 * MiB, WO_OUT = 23 * MiB, WO_XQ = 31 * MiB, WO_XO = 33 * MiB, WO_GU = 35 * MiB, WO_D = 79 * MiB;
constexpr size_t WS_XB = 440 * MiB, WS_PROJ = 504 * MiB, WS_QB = 648 * MiB, WS_KVB = 696 * MiB, WS_OB = 760 * MiB, WS_QX = 824 * MiB, WS_OX = 840 * MiB, WS_SS = 856 * MiB, WS_BAR = 898 * MiB, WS_END = 899 * MiB;
constexpr size_t WS_HFF = WS_PROJ;
static_assert(WS_HFF + (size_t)M * DFF * 2 <= WS_KVB, "HFF overlay");
constexpr int SS_MIX = 0, SS_MEM = 1, SS_FFN = 2, SS_FINAL = 12, SS_Q = 13, SS_KV = 17, SS_NBUF = 21;
constexpr int LDS_BYTES = 163840, LDS_BARST = LDS_BYTES - 64, LDS_RSTAB = 159744;
static_assert(att::ATT_LDS <= LDS_RSTAB && LDS_RSTAB + 1024 <= LDS_BARST, "LDS map");
constexpr int NWAVES = 8;

__device__ const float ROPE_INV[32] = {1.000000000e+00f, 7.498942018e-01f, 5.623413324e-01f, 4.216965139e-01f, 3.162277639e-01f, 2.371373773e-01f, 1.778279394e-01f, 1.333521456e-01f, 1.000000015e-01f, 7.498942316e-02f, 5.623413250e-02f, 4.216964915e-02f, 3.162277490e-02f, 2.371373773e-02f, 1.778279431e-02f, 1.333521400e-02f, 9.999999776e-03f, 7.498942316e-03f, 5.623413250e-03f, 4.216964822e-03f, 3.162277630e-03f, 2.371373819e-03f, 1.778279431e-03f, 1.333521446e-03f, 1.000000047e-03f, 7.498941850e-04f, 5.623413017e-04f, 4.216965172e-04f, 3.162277571e-04f, 2.371373703e-04f, 1.778279402e-04f, 1.333521504e-04f};

__device__ __forceinline__ unsigned f2bf(float f) { unsigned u = __builtin_bit_cast(unsigned, f); return (u + 0x7fffu + ((u >> 16) & 1u)) >> 16; }
__device__ __forceinline__ unsigned pk2(float lo, float hi) { return f2bf(lo) | (f2bf(hi) << 16); }
typedef _Float16 h2_t __attribute__((ext_vector_type(2)));
__device__ __forceinline__ unsigned pkh2(float lo, float hi) { h2_t v = {(_Float16)lo, (_Float16)hi}; return __builtin_bit_cast(unsigned, v); }
__device__ __forceinline__ float wave_sum(float v) {
#pragma unroll
    for (int o = 1; o < 64; o <<= 1) v += __shfl_xor(v, o);
    return v;
}
#define LDS_WAIT() asm volatile("s_waitcnt lgkmcnt(0)" ::: "memory")

struct Args { const void* in[21]; float* out; unsigned char* ws; };

__device__ __forceinline__ void tr_item(const float* __restrict__ W, int ldw, int srccol, int k0, const float* __restrict__ gain, bf16* __restrict__ WT, int K, int dstrow0, LAS float* scr, int lane, bool f16 = false) {
    if (srccol >= 0) {
        float v[32];
        const float* wp = W + (size_t)(k0 + (lane >> 5)) * ldw + srccol + (lane & 31);
#pragma unroll
        for (int i = 0; i < 32; ++i) v[i] = wp[(size_t)(2 * i) * ldw];
        if (gain) {
            const float* gp = gain + k0 + (lane >> 5);
#pragma unroll
            for (int i = 0; i < 32; ++i) v[i] *= gp[2 * i];
        }
#pragma unroll
        for (int i = 0; i < 32; ++i) scr[(2 * i + (lane >> 5)) * 33 + (lane & 31)] = v[i];
    } else {
#pragma unroll 8
        for (int i = 0; i < 32; ++i) { const int kk = 2 * i + (lane >> 5); scr[kk * 33 + (lane & 31)] = 0.f; }
    }
    LDS_WAIT(); asm volatile("" ::: "memory");
    const int c = lane & 7;
#pragma unroll
    for (int j = 0; j < 4; ++j) { const int n = (lane >> 3) + 8 * j; const LAS float* s = scr + (8 * c) * 33 + n;
        v4u o; if (f16) { o.x = pkh2(s[0 * 33], s[1 * 33]); o.y = pkh2(s[2 * 33], s[3 * 33]); o.z = pkh2(s[4 * 33], s[5 * 33]); o.w = pkh2(s[6 * 33], s[7 * 33]); }
        else { o.x = pk2(s[0 * 33], s[1 * 33]); o.y = pk2(s[2 * 33], s[3 * 33]); o.z = pk2(s[4 * 33], s[5 * 33]); o.w = pk2(s[6 * 33], s[7 * 33]); }
        *(v4u*)(WT + (size_t)(dstrow0 + n) * K + k0 + 8 * c) = o; }
    LDS_WAIT(); asm volatile("" ::: "memory");
}

constexpr int IT_IN = 32 * 144, IT_UQ = 12 * 48, IT_UKV = 8 * 64, IT_OUT = 32 * 64, IT_XQ = 32 * 16, IT_XKV = 32 * 32, IT_XO = 8 * 64, IT_GU = 32 * 352, IT_D = 88 * 64;
constexpr int IT_LAYER = IT_IN + IT_UQ + IT_UKV + IT_OUT + IT_XQ + IT_XKV + IT_XO + IT_GU + IT_D;

__device__ __forceinline__ void convert_item(const Args& a, unsigned char* ws, int l, int r, LAS float* scr, int lane) {
        unsigned char* wl = ws + WS_W + (size_t)l * W_LAYER;
        if (r < IT_IN) { const int nblk = INP / 32, kb = r / nblk, nb = r % nblk, n0 = nb * 32; int src = n0;
            if (n0 >= 4352) { const int j = n0 - 4352; src = (j == 0) ? 4352 : (j == 128 ? 4384 : -1); }
            tr_item((const float*)a.in[4] + (size_t)l * DM * INW, INW, src, kb * 64, (const float*)a.in[3] + l * DM, (bf16*)(wl + WO_IN), DM, n0, scr, lane, true); return; }
        r -= IT_IN;
        if (r < IT_UQ) { const int nblk = QW / 32, kb = r / nblk, nb = r % nblk, n0 = nb * 32; int src;
            if (n0 < 1024) src = (n0 >> 7) * 192 + (n0 & 127);
            else { const int rr = n0 - 1024, t = rr >> 8, j = rr & 255, bj = j >> 7, hl = (j & 127) >> 5; src = (4 * t + hl) * 192 + 128 + 32 * bj; }
            tr_item((const float*)a.in[8] + (size_t)l * 768 * QW, QW, src, kb * 64, (const float*)a.in[6] + l * 768, (bf16*)(wl + WO_UQ), 768, n0, scr, lane); return; }
        r -= IT_UQ;
        if (r < IT_UKV) { const int nblk = KVW / 32, kb = r / nblk, nb = r % nblk, n0 = nb * 32;
            const int src = (n0 < 1024) ? (n0 >> 7) * 256 + (n0 & 127) : ((n0 - 1024) >> 7) * 256 + 128 + (n0 & 127);
            tr_item((const float*)a.in[9] + (size_t)l * 512 * KVW, KVW, src, kb * 64, (const float*)a.in[7] + l * 512, (bf16*)(wl + WO_UKV), 512, n0, scr, lane); return; }
        r -= IT_UKV;
        if (r < IT_OUT) { const int nblk = DM / 32, kb = r / nblk, nb = r % nblk, n0 = nb * 32;
            tr_item((const float*)a.in[10] + (size_t)l * DM * DM, DM, n0, kb * 64, nullptr, (bf16*)(wl + WO_OUT), DM, n0, scr, lane); return; }
        r -= IT_OUT;
        if (r < IT_XQ) { const int nblk = XW / 32, kb = r / nblk, nb = r % nblk, n0 = nb * 32;
            tr_item((const float*)a.in[13] + (size_t)l * DM * XW, XW, n0, kb * 64, (const float*)a.in[11] + l * DM, (bf16*)(wl + WO_XQ), DM, n0, scr, lane, true); return; }
        r -= IT_XQ;
        if (r < IT_XKV) { const int nblk = 1024 / 32, kb = r / nblk, nb = r % nblk, n0 = nb * 32;
            tr_item((const float*)a.in[14] + (size_t)l * DM * 1024, 1024, n0, kb * 64, nullptr, (bf16*)(ws + WS_WXKV), DM, l * 1024 + n0, scr, lane); return; }
        r -= IT_XKV;
        if (r < IT_XO) { const int nblk = DM / 32, kb = r / nblk, nb = r % nblk, n0 = nb * 32;
            tr_item((const float*)a.in[15] + (size_t)l * XW * DM, DM, n0, kb * 64, nullptr, (bf16*)(wl + WO_XO), XW, n0, scr, lane); return; }
        r -= IT_XO;
        if (r < IT_GU) { const int nblk = 2 * DFF / 32, kb = r / nblk, nb = r % nblk, n0 = nb * 32; const int t = n0 >> 8, j = n0 & 255;
            const float* Wsrc = (const float*)a.in[j < 128 ? 17 : 18] + (size_t)l * DM * DFF;
            tr_item(Wsrc, DFF, t * 128 + (j & 127), kb * 64, (const float*)a.in[16] + l * DM, (bf16*)(wl + WO_GU), DM, n0, scr, lane, true); return; }
        r -= IT_GU;
        { const int nblk = DM / 32, kb = r / nblk, nb = r % nblk, n0 = nb * 32;
            tr_item((const float*)a.in[19] + (size_t)l * DFF * DM, DM, n0, kb * 64, nullptr, (bf16*)(wl + WO_D), DFF, n0, scr, lane); }
}
#ifndef SLOT_EXTRA
#define SLOT_EXTRA 0
#endif
#ifndef SLOT_A
#define SLOT_A 8000
#endif
#ifndef SLOT_D
#define SLOT_D 3000
#endif
constexpr int IT_EARLY = IT_IN + IT_UQ + IT_UKV + IT_OUT + IT_XQ + IT_XKV + SLOT_EXTRA;
constexpr int IT_SLOT_A = IT_EARLY + SLOT_A, IT_SLOT_D = IT_SLOT_A + SLOT_D;
__device__ __forceinline__ void convert_range(const Args& a, LAS unsigned char* lds, int l, int r_lo, int r_hi) {
    int tid = threadIdx.x; asm volatile("" : "+v"(tid));
    const int lane = tid & 63, wave = __builtin_amdgcn_readfirstlane(tid >> 6);
    const int G = gridDim.x, first = G / 2, nidle = G - first;
    LAS float* scr = (LAS float*)(lds + wave * 16384);
    for (int r = r_lo + ((int)blockIdx.x - first) * NWAVES + wave; r < r_hi; r += nidle * NWAVES) convert_item(a, a.ws, l, r, scr, lane);
}

__device__ __forceinline__ void prologue(const Args& a, LAS unsigned char* lds) {
    int tid = threadIdx.x; asm volatile("" : "+v"(tid));
    const int lane = tid & 63, wave = __builtin_amdgcn_readfirstlane(tid >> 6);
    const int G = gridDim.x, gw = blockIdx.x * NWAVES + wave, NGW = G * NWAVES;
    unsigned char* ws = a.ws;
    LAS float* scr = (LAS float*)(lds + wave * 16384);
    for (int it = gw; it < DEPTH * IT_EARLY; it += NGW) convert_item(a, ws, it / IT_EARLY, it % IT_EARLY, scr, lane);
    float* ss = (float*)(ws + WS_SS);
    for (int m = gw; m < M + BATCH * NMEM; m += NGW) {
        const bool is_x = m < M; const int row = is_x ? m : m - M;
        const f32x4* xr = (const f32x4*)((const float*)(is_x ? a.in[0] : a.in[1]) + (size_t)row * DM) + lane;
        f32x4 v[8]; float s = 0.f;
#pragma unroll
        for (int j = 0; j < 8; ++j) { v[j] = xr[64 * j]; s += (v[j][0] * v[j][0] + v[j][1] * v[j][1]) + (v[j][2] * v[j][2] + v[j][3] * v[j][3]); }
        s = wave_sum(s);
        unsigned long long* o8 = (unsigned long long*)((bf16*)(ws + (is_x ? WS_XB : WS_MEMN)) + (size_t)row * DM) + lane;
        if (is_x) { if (lane < 32) ss[(size_t)row * 32 + lane] = (lane == 0) ? s : 0.f;
#pragma unroll
            for (int j = 0; j < 8; ++j) o8[64 * j] = (unsigned long long)pkh2(v[j][0], v[j][1]) | ((unsigned long long)pkh2(v[j][2], v[j][3]) << 32);
        } else { const float rstd = 1.f / sqrtf(s * (1.f / DM) + EPS); const f32x4* gr = (const f32x4*)a.in[12] + lane;
#pragma unroll
            for (int j = 0; j < 8; ++j) { const f32x4 g = gr[64 * j]; o8[64 * j] = (unsigned long long)pk2(v[j][0] * rstd * g[0], v[j][1] * rstd * g[1]) | ((unsigned long long)pk2(v[j][2] * rstd * g[2], v[j][3] * rstd * g[3]) << 32); }
        }
    }
    const int gt = blockIdx.x * (NWAVES * 64) + tid, NGT = G * NWAVES * 64;
    float* cs = (float*)(ws + WS_COS); float* sn = (float*)(ws + WS_SIN); const int* pos = (const int*)a.in[2];
    for (int i = gt; i < M * 32; i += NGT) {
        const float ang = (float)pos[i >> 5] * ROPE_INV[i & 31];
        double t = (double)ang * 0.15915494309189535; t -= __builtin_rint(t);
        cs[i] = __builtin_amdgcn_cosf((float)t); sn[i] = __builtin_amdgcn_sinf((float)t);
    }
}

#define XB_TMO      128
#define XB_XCNT(j)  (256  + 64 * (j))
#define XB_XSUB(j)  (1280 + 64 * (j))
#define XB_XGEN(j)  (2304 + 64 * (j))
#define XB_TOP      3328
#define XB_TOPGEN   3392
#define XCD_BAR_WORDS 3456
#define XB_SPIN_CAP (1u << 18)

__device__ __forceinline__ unsigned xb_ld(unsigned* p)              { return __hip_atomic_load(p, __ATOMIC_RELAXED, __HIP_MEMORY_SCOPE_AGENT); }
__device__ __forceinline__ unsigned xb_add(unsigned* p, unsigned v) { return __hip_atomic_fetch_add(p, v, __ATOMIC_RELAXED, __HIP_MEMORY_SCOPE_AGENT); }
__device__ __forceinline__ unsigned xb_xcc_id() { return (unsigned)__builtin_amdgcn_s_getreg((3 << 11) | 20) & 0xFu; }
#define XB_SPIN(cond, bar) do { unsigned _sp = 0; while (cond) { __builtin_amdgcn_s_sleep(1); \
    if ((++_sp & 255u) == 0u) { if (xb_ld(&(bar)[XB_TMO])) break; if (_sp > XB_SPIN_CAP) { atomicAdd(&(bar)[XB_TMO], 1u); break; } } } } while (0)

struct XcdBarrier {
    unsigned* bar; unsigned x;
    volatile LAS unsigned* st;
};

__device__ __forceinline__ XcdBarrier xcd_barrier_post(unsigned* bar, volatile LAS unsigned* st) {
    XcdBarrier b; b.bar = bar; b.x = xb_xcc_id(); b.st = st;
    if (threadIdx.x == 0) (void)xb_add(&bar[XB_XCNT(b.x)], 1u);
    return b;
}
__device__ __forceinline__ void xcd_barrier_complete(unsigned* bar, unsigned x, unsigned& nloc, unsigned& nx) {
    const unsigned G = gridDim.x * gridDim.y * gridDim.z;
    unsigned sum, cnt, mine, sp = 0u;
    for (;;) {
        sum = 0u; cnt = 0u; mine = 0u;
#pragma unroll
        for (unsigned j = 0; j < 16; ++j) { const unsigned c = xb_ld(&bar[XB_XCNT(j)]); sum += c; cnt += (c > 0u) ? 1u : 0u; mine = (j == x) ? c : mine; }
        if (sum == G) break;
        __builtin_amdgcn_s_sleep(1);
        if ((++sp & 255u) == 0u) { if (xb_ld(&bar[XB_TMO])) break; if (sp > XB_SPIN_CAP) { atomicAdd(&bar[XB_TMO], 1u); break; } }
    }
    nloc = mine > 0u ? mine : 1u; nx = cnt > 0u ? cnt : 1u;
}

__device__ __forceinline__ void xcd_barrier(const XcdBarrier& b) {
    asm volatile("s_waitcnt vmcnt(0)" ::: "memory");
    __syncthreads();
    if (threadIdx.x == 0) {
        unsigned* bar = b.bar;
        __builtin_amdgcn_s_waitcnt(0);
        unsigned nloc = b.st[0], nx = b.st[1];
        if (nloc == 0u) { xcd_barrier_complete(bar, b.x, nloc, nx); b.st[0] = nloc; b.st[1] = nx; }
        const unsigned old = xb_add(&bar[XB_XSUB(b.x)], 1u);
        const unsigned gen = old / nloc;
        if (old + 1u == (gen + 1u) * nloc) {
            __builtin_amdgcn_fence(__ATOMIC_RELEASE, "agent");
            asm volatile("s_waitcnt vmcnt(0)" ::: "memory");
            const unsigned og = xb_add(&bar[XB_TOP], 1u);
            const unsigned tg = og / nx;
            if (og + 1u == (tg + 1u) * nx) xb_add(&bar[XB_TOPGEN], 1u);
            else XB_SPIN(xb_ld(&bar[XB_TOPGEN]) == tg, bar);
            __builtin_amdgcn_fence(__ATOMIC_ACQUIRE, "agent");
            xb_add(&bar[XB_XGEN(b.x)], 1u);
            asm volatile("s_waitcnt vmcnt(0)" ::: "memory");
        } else {
            XB_SPIN(xb_ld(&bar[XB_XGEN(b.x)]) == gen, bar);
            __builtin_amdgcn_fence(__ATOMIC_ACQUIRE, "agent");
            asm volatile("s_waitcnt vmcnt(0)" ::: "memory");
        }
    }
    __syncthreads();
}

__device__ __forceinline__ void attn_mix_phase(const Args& a, char* lds, int l, int skip = 0) {
    unsigned char* ws = a.ws;
    const bf16* PROJ = (const bf16*)(ws + WS_PROJ); const bf16* QB = (const bf16*)(ws + WS_QB); const bf16* KVB = (const bf16*)(ws + WS_KVB); const bf16* KR = (const bf16*)(ws + WS_KR);
    bf16* OB = (bf16*)(ws + WS_OB);
#pragma unroll 1
    for (int ui = blockIdx.x; ui < 1024; ui += gridDim.x) {
        if ((skip == 1 && ui < 512) || (skip == 2 && ui >= 512)) continue;
        if (ui < 512) {
            const int half = ui >> 8, it = ui & 255, xcd = it & 7, slot = it >> 3, bh = xcd * 4 + (slot >> 3), p = slot & 7, qb = half ? p : 15 - p, b = bh >> 3, h = bh & 7;
            const size_t qrow = (size_t)b * SEQ + 256 * qb, krow = (size_t)b * SEQ;
#ifndef NO_M2
            att::attn_unit<2>(lds, QB + qrow * QW + h * 128, QB + qrow * QW + 1024 + h * 64, KVB + krow * KVW + h * 128, KVB + krow * KVW + 1024 + h * 128, KR + krow * 64,
                              OB + qrow * DM + 1024 + h * 128, QW, QW, KVW, DM, 4 * qb + 4, 4 * qb, 0, nullptr);
#endif
        } else {
            const int it = ui - 512, xcd = it & 7, slot = it >> 3, bh = xcd * 4 + (slot >> 4), qb = slot & 15, b = bh >> 3, h = bh & 7;
            const int qc0 = 4 * qb, kc0 = qc0 > 8 ? qc0 - 8 : 0;
            const size_t qrow = (size_t)b * SEQ + 256 * qb, krow = (size_t)b * SEQ + 64 * kc0;
#ifndef NO_M1
            att::attn_unit<1>(lds, PROJ + qrow * INP + h * 128, nullptr, PROJ + krow * INP + 1024 + h * 128, PROJ + krow * INP + 2048 + h * 128, nullptr,
                              OB + qrow * DM + h * 128, INP, 0, INP, DM, qc0 + 4 - kc0, qc0, kc0, (const float*)a.in[5] + ((size_t)l * 8 + h) * 257);
#endif
        }
    }
}
__device__ __forceinline__ void attn_cross_phase(const Args& a, char* lds, int l) {
    unsigned char* ws = a.ws;
    const bf16* QX = (const bf16*)(ws + WS_QX); const bf16* MKV = (const bf16*)(ws + WS_MEMKV); bf16* OX = (bf16*)(ws + WS_OX);
#pragma unroll 1
    for (int ui = blockIdx.x; ui < 256; ui += gridDim.x) {
        const int xcd = ui & 7, slot = ui >> 3, bh = xcd * 2 + (slot >> 4), qb = slot & 15, b = bh >> 2, h = bh & 3;
        const size_t qrow = (size_t)b * SEQ + 256 * qb, krow = (size_t)b * NMEM;
#ifndef NO_M0
        att::attn_unit<0>(lds, QX + qrow * XW + h * 128, nullptr, MKV + krow * 4096 + l * 1024 + h * 128, MKV + krow * 4096 + l * 1024 + 512 + h * 128, nullptr,
                          OX + qrow * XW + h * 128, XW, 0, 4096, XW, 4, 0, 0, nullptr);
#endif
    }
}

__global__ void __launch_bounds__(NWAVES * 64) mega_fwd(Args a) {
    extern __shared__ __attribute__((aligned(16))) unsigned char lds[];
    cg::grid_group grid = cg::this_grid();
    LAS unsigned char* ldsl = (LAS unsigned char*)lds;
    unsigned char* ws = a.ws;
    float* ss = (float*)(ws + WS_SS);
    const float* cs = (const float*)(ws + WS_COS); const float* sn = (const float*)(ws + WS_SIN);
    bf16* XB = (bf16*)(ws + WS_XB); bf16* PROJ = (bf16*)(ws + WS_PROJ); bf16* QB = (bf16*)(ws + WS_QB); bf16* KVB = (bf16*)(ws + WS_KVB);
    bf16* OB = (bf16*)(ws + WS_OB); bf16* QX = (bf16*)(ws + WS_QX); bf16* OX = (bf16*)(ws + WS_OX); bf16* HFF = (bf16*)(ws + WS_HFF);
    const int G = gridDim.x, c = blockIdx.x;
#define GRID_SYNC() do { asm volatile("s_waitcnt vmcnt(0) lgkmcnt(0)" ::: "memory"); __syncthreads(); \
        if (threadIdx.x < 64) { __builtin_amdgcn_fence(__ATOMIC_RELEASE, "agent"); asm volatile("s_waitcnt vmcnt(0)" ::: "memory"); }     \
        __syncthreads(); grid.sync(); \
        __builtin_amdgcn_fence(__ATOMIC_ACQUIRE, "agent"); asm volatile("s_waitcnt vmcnt(0)" ::: "memory"); __syncthreads(); } while (0)

    unsigned* barw = (unsigned*)(ws + WS_BAR);
    if (threadIdx.x < 2) ((volatile LAS unsigned*)(ldsl + LDS_BARST))[threadIdx.x] = 0u;
    __syncthreads();
    const XcdBarrier xbar = xcd_barrier_post(barw, (volatile LAS unsigned*)(ldsl + LDS_BARST));
    if (a.ws == nullptr) GRID_SYNC();
    prologue(a, ldsl);
#ifdef PROBE_DUP_PRO
    __syncthreads(); prologue(a, ldsl);
#endif
    xcd_barrier(xbar);

#pragma unroll 1
    for (int s = 0; s < 1 + DEPTH * 10; ++s) {
        const int l = s == 0 ? 0 : (s - 1) / 10, st = s == 0 ? -1 : (s - 1) % 10;
        unsigned char* wl = ws + WS_W + (size_t)l * W_LAYER;
        int kind; bool sync_after = true;
        pg8::Gemm g{nullptr, nullptr, M, 0, 0, 0, 0};
        pg8::EpiBf eb{nullptr, 0, nullptr, 0.f, 8, 0, 1.f, nullptr, 0, 0, nullptr, 0, 0, 1 << 30, nullptr, 0, 0, cs, sn, (LAS float*)(ldsl + LDS_RSTAB), -1};
        pg8::EpiRes er{nullptr, (_Float16*)XB, nullptr, DM, 0};
        if (st == -1) {
            kind = 0; g = pg8::Gemm{(const bf16*)(ws + WS_MEMN), (const bf16*)(ws + WS_WXKV), BATCH * NMEM, 4096, DM, DM, DM};
            eb.O = (bf16*)(ws + WS_MEMKV); eb.ldc = 4096; sync_after = false;
        } else if (st == 0) {
            kind = 0; g = pg8::Gemm{XB, (const bf16*)(wl + WO_IN), M, INP, DM, DM, DM};
            eb.O = PROJ; eb.ldc = INP; eb.ss = ss + (size_t)(l * 3 + SS_MIX) * M * 32; eb.inv_w = 1.f / DM; eb.nscale = 4; eb.scale = 0.08838834764831845f * LOG2E;
            eb.ssA = ss + (size_t)(SS_Q + l) * M * 32; eb.a_lo = 12; eb.a_hi = 15; eb.ssB = ss + (size_t)(SS_KV + l) * M * 32; eb.b_lo = 15; eb.b_hi = 17;
            eb.rope_lo = 17; eb.R = (bf16*)(ws + WS_KR); eb.ldr = 64; eb.rmode = 0;
        } else if (st == 1) {
            kind = 0; g = pg8::Gemm{PROJ + 3072, (const bf16*)(wl + WO_UQ), M, QW, 768, INP, 768};
            eb.O = QB; eb.ldc = QW; eb.ss = ss + (size_t)(SS_Q + l) * M * 32; eb.inv_w = 1.f / 768.f; eb.nsl4 = 3; eb.nscale = 6; eb.scale = 0.07216878364870322f * LOG2E;
            eb.rope_lo = 4; eb.R = QB + 1024; eb.ldr = QW; eb.rmode = 1; sync_after = false;
        } else if (st == 2) {
            kind = 0; g = pg8::Gemm{PROJ + 3840, (const bf16*)(wl + WO_UKV), M, KVW, 512, INP, 512};
            eb.O = KVB; eb.ldc = KVW; eb.ss = ss + (size_t)(SS_KV + l) * M * 32; eb.inv_w = 1.f / 512.f; eb.nsl4 = 2;
        } else if (st == 3) { kind = 3;
        } else if (st == 4) {
            kind = 1; g = pg8::Gemm{OB, (const bf16*)(wl + WO_OUT), M, DM, DM, DM, DM};
            er.base32 = nullptr;
            er.ssn = ss + (size_t)(l * 3 + SS_MEM) * M * 32;
        } else if (st == 5) {
            kind = 0; g = pg8::Gemm{XB, (const bf16*)(wl + WO_XQ), M, XW, DM, DM, DM};
            eb.O = QX; eb.ldc = XW; eb.ss = ss + (size_t)(l * 3 + SS_MEM) * M * 32; eb.inv_w = 1.f / DM; eb.nscale = 2; eb.scale = 0.08838834764831845f * LOG2E;
        } else if (st == 6) { kind = 4;
        } else if (st == 7) {
            kind = 1; g = pg8::Gemm{OX, (const bf16*)(wl + WO_XO), M, DM, XW, XW, XW};
            er.ssn = ss + (size_t)(l * 3 + SS_FFN) * M * 32;
        } else if (st == 8) {
            kind = 2; g = pg8::Gemm{XB, (const bf16*)(wl + WO_GU), M, 2 * DFF, DM, DM, DM};
        } else {
            kind = 1; g = pg8::Gemm{HFF, (const bf16*)(wl + WO_D), M, DM, DFF, DFF, DFF};
            er.ssn = ss + (size_t)(l == DEPTH - 1 ? SS_FINAL : (l + 1) * 3 + SS_MIX) * M * 32;
        }
#ifdef PROBE_DUP_ST
        const int reps = (st >= 0 && ((PROBE_DUP_ST >> st) & 1)) ? 2 : 1;
#else
        const int reps = 1;
#endif
#pragma unroll 1
        for (int rep = 0; rep < reps; ++rep) {
#ifdef PROBE_DUP_ST
        if (rep == 1 && kind == 1) { er.base32 = nullptr; er.xh = (_Float16*)KVB; er.ssn = (float*)(ws + WS_QX);
#ifdef PROBE_PF
            er.pf = PROBE_PF;
#endif
#ifdef PROBE_LDC
            er.ldc = PROBE_LDC;
#endif
        }
#endif
        if (kind <= 2) {
#ifndef NO_GEMM
            pg8::StaticOrder S; S.init(g.M, g.N, G, c, (kind == 1 && (g.M / 256) % 8 == 0) ? 1 : 0);
            if (kind == 0 && (st == 0 || st == 5)) pg8::gemm_phase<pg8::EpiBf, pg8::StaticOrder, true, true, true>(ldsl, g, S, eb);
            else if (kind == 0) pg8::gemm_phase<pg8::EpiBf, pg8::StaticOrder, true, true>(ldsl, g, S, eb);
            else if (kind == 1) pg8::gemm_phase<pg8::EpiRes, pg8::StaticOrder, true, true>(ldsl, g, S, er);
            else { pg8::EpiGU eg{HFF, DFF, ss + (size_t)(l * 3 + SS_FFN) * M * 32, 1.f / DM, (LAS float*)(ldsl + LDS_RSTAB), -1}; pg8::gemm_phase<pg8::EpiGU, pg8::StaticOrder, true, true, true>(ldsl, g, S, eg); }
#endif
            if ((int)blockIdx.x >= G / 2 && rep == 0) {
                if (st == 0) convert_range(a, ldsl, l, IT_EARLY, IT_SLOT_A);
                else if (st == 1) convert_range(a, ldsl, l, IT_SLOT_A, IT_SLOT_D);
                else if (st == 5) convert_range(a, ldsl, l, IT_SLOT_D, IT_LAYER);
            }
        }
#ifndef NO_ATT
#ifdef PROBE_SKIP
        else if (kind == 3) attn_mix_phase(a, (char*)lds, l, rep == 1 ? PROBE_SKIP : 0);
#else
        else if (kind == 3) attn_mix_phase(a, (char*)lds, l);
#endif
        else attn_cross_phase(a, (char*)lds, l);
#endif
        }
        if (sync_after) xcd_barrier(xbar); else __syncthreads();
    }
    {
        int tid = threadIdx.x; asm volatile("" : "+v"(tid));
        const int lane = tid & 63, wave = tid >> 6, gw = c * NWAVES + wave, NGW = G * NWAVES;
        typedef _Float16 f16x4v __attribute__((ext_vector_type(4)));
        const f32x4* gr = (const f32x4*)a.in[20] + lane;
        for (int m = gw; m < M; m += NGW) {
            float sv = ss[((size_t)SS_FINAL * M + m) * 32 + (lane & 31)];
#pragma unroll
            for (int o = 1; o < 32; o <<= 1) sv += __shfl_xor(sv, o);
            const float rstd = 1.f / sqrtf(sv * (1.f / DM) + EPS);
            const f16x4v* xr = (const f16x4v*)((const _Float16*)XB + (size_t)m * DM) + lane;
            f32x4* orow = (f32x4*)(a.out + (size_t)m * DM) + lane;
#pragma unroll
            for (int j = 0; j < 8; ++j) { const f32x4 v = __builtin_convertvector(xr[64 * j], f32x4), gg = gr[64 * j]; orow[64 * j] = v * rstd * gg; }
        }
    }
}

extern "C" void kernel_launch(void* const* d_in, const int* in_sizes, int n_in, void* d_out, int out_size, void* d_ws, size_t ws_size, hipStream_t stream) {
    static int grid = 0;
    if (grid == 0) {
        if (n_in != 21 || out_size != M * DM || ws_size < WS_END) { fprintf(stderr, "kernel_launch: unexpected shapes: n_in %d out %d ws %zu (need %zu)\n", n_in, out_size, ws_size, (size_t)WS_END); grid = -1; return; }
        int dev = 0, cus = 0, per_cu = 0;
        hipGetDevice(&dev); hipDeviceGetAttribute(&cus, hipDeviceAttributeMultiprocessorCount, dev);
        if (hipFuncSetAttribute((const void*)mega_fwd, hipFuncAttributeMaxDynamicSharedMemorySize, LDS_BYTES) != hipSuccess) { fprintf(stderr, "kernel_launch: hipFuncSetAttribute failed\n"); grid = -1; return; }
        if (hipOccupancyMaxActiveBlocksPerMultiprocessor(&per_cu, (const void*)mega_fwd, NWAVES * 64, LDS_BYTES) != hipSuccess || per_cu < 1) { fprintf(stderr, "kernel_launch: occupancy query says %d\n", per_cu); per_cu = 1; }
        (void)hipGetLastError();
        grid = cus;
    }
    if (grid < 0) return;
    if (hipMemsetAsync((char*)d_ws + WS_BAR, 0, XCD_BAR_WORDS * 4, stream) != hipSuccess) { fprintf(stderr, "kernel_launch: hipMemsetAsync failed\n"); return; }
    Args a{};
    for (int i = 0; i < 21; ++i) a.in[i] = d_in[i];
    a.out = (float*)d_out; a.ws = (unsigned char*)d_ws;
    void* args[] = {&a};
    hipError_t e = hipLaunchCooperativeKernel((const void*)mega_fwd, dim3(grid), dim3(NWAVES * 64), args, LDS_BYTES, stream);
    if (e != hipSuccess) fprintf(stderr, "kernel_launch: cooperative launch failed: %s (grid %d)\n", hipGetErrorString(e), grid);
}
```

```cpp
#include <hip/hip_runtime.h>
#include <hip/hip_cooperative_groups.h>
#include <cstdio>
#include <cstdint>
namespace cg = cooperative_groups;
namespace pg8 {
#define PG8_LAS __attribute__((address_space(3)))
typedef unsigned short bf16_t;
typedef short bf16x8 __attribute__((ext_vector_type(8)));
typedef float f32x4 __attribute__((ext_vector_type(4)));
typedef unsigned u32x4 __attribute__((ext_vector_type(4)));
constexpr int BM = 256, BK = 64, HALF = 128, HTB = HALF * BK * 2  , STAGE_BYTES = 8 * HTB, NXCD = 8, WGM = 8;

__host__ __device__ __forceinline__ int lds_byte(int r, int c) { const int st = (r >> 4) * 2 + (c >> 5), rr = r & 15, cc = c & 31, ob = rr * 64 + cc * 2; return st * 1024 + (ob ^ (((ob >> 9) & 1) << 5)); }
__host__ __device__ __forceinline__ void stage_rc(int b, int& R, int& C) { const int st = b / 1024, sb = b % 1024, swz = sb ^ (((sb >> 9) & 1) << 5); R = (st >> 1) * 16 + swz / 64; C = (st & 1) * 32 + (swz % 64) / 2; }
__host__ __device__ __forceinline__ int perm32(int rho) { const int n = rho >> 4, i = rho & 15; return 8 * (i >> 2) + 4 * n + (i & 3); }

struct Unit { int pm, pn; };
struct Gemm { const bf16_t* A; const bf16_t* Bt; int M, N, K, lda, ldb; };

struct StaticOrder {
    int nM, nN, nwg, G, c, pn_fast;
    __host__ __device__ void init(int M, int N, int G_, int c_, int pn_fast_ = 0) { nM = M / BM; nN = N / BM; nwg = nM * nN; G = G_; c = c_; pn_fast = pn_fast_; }
    __host__ __device__ bool next(int i, Unit& u) const {
        const long L = (long)i * G + c; if (L >= nwg) return false;
        int wgid = (int)L; { const int q = nwg / NXCD, r = nwg % NXCD, xcd = wgid % NXCD, off = wgid / NXCD; wgid = (xcd < r ? xcd * (q + 1) : r * (q + 1) + (xcd - r) * q) + off; }
        const int nig = WGM * nN, gid = wgid / nig, fm = gid * WGM, gsz = (nM - fm) < WGM ? (nM - fm) : WGM;
        if (pn_fast) { u.pm = fm + (wgid % nig) / nN; u.pn = (wgid % nig) % nN; } else { u.pm = fm + ((wgid % nig) % gsz); u.pn = (wgid % nig) / gsz; }
        return true;
    }
    __device__ __forceinline__ void a_ready(const Unit&) const {}
    __device__ __forceinline__ void done(const Unit&) const {}
};
__device__ __forceinline__ unsigned cvt_pk_bf16(float lo, float hi) { unsigned r; asm volatile("v_cvt_pk_bf16_f32 %0, %1, %2" : "=v"(r) : "v"(lo), "v"(hi)); return r; }
typedef _Float16 f16x8 __attribute__((ext_vector_type(8)));
template <class Epi, class Sched, bool ALIGN_EPI = false, bool SP2 = false, bool F16 = false>
__device__ __forceinline__ void gemm_phase(PG8_LAS unsigned char* lds, const Gemm g, const Sched& S, const Epi& E) {
    int tid = threadIdx.x; asm volatile("" : "+v"(tid));
    const int wid = __builtin_amdgcn_readfirstlane(tid >> 6), lane = tid & 63, wr = wid >> 2, wc = wid & 3, fr = lane & 15, fq = lane >> 4;
    const int K = g.K, nt = K / BK;
    unsigned voffA[2], voffB[2];
#pragma unroll
    for (int i = 0; i < 2; ++i) { int R, C; stage_rc(tid * 16 + i * 8192, R, C); const int Rb = Epi::PERM ? ((R & ~31) + perm32(R & 31)) : R;
        voffA[i] = (unsigned)(R * g.lda + C) * 2u; voffB[i] = (unsigned)(Rb * g.ldb + C) * 2u; }
    const size_t kstep = (size_t)(BK * 2);
    const size_t hstepA = (size_t)HALF * g.lda * 2, hstepB = (size_t)HALF * g.ldb * 2;
    const size_t tstepA = 2 * hstepA, tstepB = 2 * hstepB;
    const unsigned ldsw = (unsigned)wid * 1024u;
    const int aoff = lds_byte(wr * 64 + fr, fq * 8), boff = lds_byte(wc * 32 + fr, fq * 8);
#define PG8_SA(b, h) (((b) * 2 + (h)) * HTB)
#define PG8_SB(b, h) ((4 + (b) * 2 + (h)) * HTB)
#define PG8_STAGE(bufoff, gbase, voff) do { _Pragma("unroll") for (int _i = 0; _i < 2; ++_i) \
        __builtin_amdgcn_global_load_lds((const unsigned*)((const char*)(gbase) + (voff)[_i]), (PG8_LAS unsigned*)(lds + (bufoff) + ldsw + _i * 8192), 16, 0, 0); } while (0)
#define PG8_LDA(dst, b, h) do { _Pragma("unroll") for (int m = 0; m < 4; ++m) _Pragma("unroll") for (int k = 0; k < 2; ++k) dst[m][k] = *(const PG8_LAS bf16x8*)(lds + PG8_SA(b, h) + aoff + m * 2048 + k * 1024); } while (0)
#define PG8_LDB(dst, b, h) do { _Pragma("unroll") for (int n = 0; n < 2; ++n) _Pragma("unroll") for (int k = 0; k < 2; ++k) dst[n][k] = *(const PG8_LAS bf16x8*)(lds + PG8_SB(b, h) + boff + n * 2048 + k * 1024); } while (0)
#define PG8_MMA(ai, bj, At, Bt) do { __builtin_amdgcn_s_setprio(1); _Pragma("unroll") for (int m = 0; m < 4; ++m) _Pragma("unroll") for (int n = 0; n < 2; ++n) _Pragma("unroll") for (int k = 0; k < 2; ++k) \
        { if constexpr (F16) acc[ai][bj][m][n] = __builtin_amdgcn_mfma_f32_16x16x32_f16(__builtin_bit_cast(f16x8, Bt[n][k]), __builtin_bit_cast(f16x8, At[m][k]), acc[ai][bj][m][n], 0, 0, 0); \
          else acc[ai][bj][m][n] = __builtin_amdgcn_mfma_f32_16x16x32_bf16(Bt[n][k], At[m][k], acc[ai][bj][m][n], 0, 0, 0); } __builtin_amdgcn_s_setprio(0); } while (0)
#define PG8_WAIT_V(n) asm volatile("s_waitcnt vmcnt(" #n ")" ::: "memory")
#define PG8_WAIT_L(n) asm volatile("s_waitcnt lgkmcnt(" #n ")" ::: "memory")
#define PG8_BAR __builtin_amdgcn_s_barrier()
#define PG8_SCHED __builtin_amdgcn_sched_barrier(0)
    Unit cur, nxt; int ui = 0;
    if (!S.next(0, cur)) return;
    f32x4 acc[2][2][4][2];
#pragma unroll
    for (int a = 0; a < 2; ++a)
#pragma unroll
        for (int b = 0; b < 2; ++b)
#pragma unroll
            for (int m = 0; m < 4; ++m)
#pragma unroll
                for (int n = 0; n < 2; ++n) acc[a][b][m][n] = (f32x4){0.f, 0.f, 0.f, 0.f};
    bf16x8 At[4][2], B0[2][2], B1[2][2];
    const char* cA = (const char*)g.A + (size_t)cur.pm * tstepA; const char* cB = (const char*)g.Bt + (size_t)cur.pn * tstepB;
    S.a_ready(cur);
    if constexpr (SP2) {
        PG8_STAGE(PG8_SB(0, 0), cB, voffB); PG8_STAGE(PG8_SB(0, 1), cB + hstepB, voffB); PG8_STAGE(PG8_SA(0, 0), cA, voffA); PG8_STAGE(PG8_SA(0, 1), cA + hstepA, voffA);
        if (wr == 1) PG8_BAR;
        PG8_WAIT_V(2); PG8_BAR;
        PG8_STAGE(PG8_SB(1, 0), cB + kstep, voffB); PG8_STAGE(PG8_SA(1, 0), cA + kstep, voffA); PG8_STAGE(PG8_SB(1, 1), cB + hstepB + kstep, voffB);
        PG8_WAIT_V(6); PG8_BAR;
    } else {
        PG8_STAGE(PG8_SB(0, 0), cB, voffB); PG8_STAGE(PG8_SA(0, 0), cA, voffA); PG8_STAGE(PG8_SB(0, 1), cB + hstepB, voffB); PG8_STAGE(PG8_SA(0, 1), cA + hstepA, voffA);
        if (wr == 1) PG8_BAR;
        PG8_WAIT_V(4); PG8_BAR;
        PG8_STAGE(PG8_SB(1, 0), cB + kstep, voffB); PG8_STAGE(PG8_SA(1, 0), cA + kstep, voffA); PG8_STAGE(PG8_SB(1, 1), cB + hstepB + kstep, voffB);
        PG8_WAIT_V(6); PG8_BAR;
    }
    for (;;) {
        const bool has_next = S.next(ui + 1, nxt);
        const char* nA = has_next ? (const char*)g.A + (size_t)nxt.pm * tstepA : cA; const char* nB = has_next ? (const char*)g.Bt + (size_t)nxt.pn * tstepB : cB;
        for (int t = 0; t < nt; t += 2) {
            const bool last = (t == nt - 2);
            const char* a1 = cA + (size_t)(t + 1) * kstep;
            const char* a2 = last ? nA : cA + (size_t)(t + 2) * kstep; const char* b2 = last ? nB : cB + (size_t)(t + 2) * kstep;
            const char* a3 = a2 + kstep; const char* b3 = b2 + kstep;
            if (last && has_next) S.a_ready(nxt);
            if constexpr (SP2) {
            PG8_LDB(B0, 0, 0); PG8_LDB(B1, 0, 1); PG8_SCHED; PG8_LDA(At, 0, 0); PG8_STAGE(PG8_SA(1, 1), a1 + hstepA, voffA);
            PG8_WAIT_V(8); PG8_WAIT_L(0); PG8_BAR; PG8_MMA(0, 0, At, B0); PG8_MMA(0, 1, At, B1); PG8_BAR; PG8_SCHED;
            PG8_LDA(At, 0, 1); PG8_STAGE(PG8_SB(0, 0), b2, voffB); PG8_STAGE(PG8_SB(0, 1), b2 + hstepB, voffB); PG8_STAGE(PG8_SA(0, 0), a2, voffA);
            PG8_WAIT_V(8); PG8_WAIT_L(0); PG8_BAR; PG8_MMA(1, 0, At, B0); PG8_MMA(1, 1, At, B1); PG8_BAR; PG8_SCHED;
            PG8_LDB(B0, 1, 0); PG8_LDB(B1, 1, 1); PG8_SCHED; PG8_LDA(At, 1, 0); PG8_STAGE(PG8_SA(0, 1), a2 + hstepA, voffA);
            PG8_WAIT_V(8); PG8_WAIT_L(0); PG8_BAR; PG8_MMA(0, 0, At, B0); PG8_MMA(0, 1, At, B1); PG8_BAR; PG8_SCHED;
            PG8_LDA(At, 1, 1); PG8_STAGE(PG8_SB(1, 0), b3, voffB); PG8_STAGE(PG8_SB(1, 1), b3 + hstepB, voffB); PG8_STAGE(PG8_SA(1, 0), a3, voffA);
            PG8_WAIT_V(8); PG8_WAIT_L(0); PG8_BAR; PG8_MMA(1, 0, At, B0); PG8_MMA(1, 1, At, B1); PG8_BAR; PG8_SCHED;
            } else {
            PG8_LDB(B0, 0, 0); PG8_SCHED; PG8_LDA(At, 0, 0); PG8_STAGE(PG8_SA(1, 1), a1 + hstepA, voffA);
            PG8_WAIT_L(8); PG8_BAR; PG8_WAIT_L(0); PG8_MMA(0, 0, At, B0); PG8_BAR; PG8_SCHED;
            PG8_LDB(B1, 0, 1); PG8_STAGE(PG8_SB(0, 0), b2, voffB);
            PG8_BAR; PG8_WAIT_L(0); PG8_MMA(0, 1, At, B1); PG8_BAR;
            PG8_LDA(At, 0, 1); PG8_STAGE(PG8_SA(0, 0), a2, voffA);
            PG8_BAR; PG8_WAIT_L(0); PG8_MMA(1, 0, At, B0); PG8_BAR; PG8_SCHED;
            PG8_STAGE(PG8_SB(0, 1), b2 + hstepB, voffB);
            PG8_WAIT_V(6); PG8_BAR; PG8_MMA(1, 1, At, B1); PG8_BAR;
            PG8_LDB(B0, 1, 0); PG8_SCHED; PG8_LDA(At, 1, 0); PG8_STAGE(PG8_SA(0, 1), a2 + hstepA, voffA);
            PG8_WAIT_L(8); PG8_BAR; PG8_WAIT_L(0); PG8_MMA(0, 0, At, B0); PG8_BAR; PG8_SCHED;
            PG8_LDB(B1, 1, 1); PG8_STAGE(PG8_SB(1, 0), b3, voffB);
            PG8_BAR; PG8_WAIT_L(0); PG8_MMA(0, 1, At, B1); PG8_BAR;
            PG8_LDA(At, 1, 1); PG8_STAGE(PG8_SA(1, 0), a3, voffA);
            PG8_BAR; PG8_WAIT_L(0); PG8_MMA(1, 0, At, B0); PG8_BAR; PG8_SCHED;
            PG8_STAGE(PG8_SB(1, 1), b3 + hstepB, voffB);
            PG8_WAIT_V(6); PG8_BAR; PG8_MMA(1, 1, At, B1); PG8_BAR;
            }
        }
        if constexpr (ALIGN_EPI) { if (wr == 0) PG8_BAR; }
        if constexpr (!Epi::AFTER_DRAIN) { E(acc, cur, wr, wc, fr, fq); S.done(cur); }
        if (!has_next) break;
#pragma unroll
        for (int a = 0; a < 2; ++a)
#pragma unroll
            for (int b = 0; b < 2; ++b)
#pragma unroll
                for (int m = 0; m < 4; ++m)
#pragma unroll
                    for (int n = 0; n < 2; ++n) acc[a][b][m][n] = (f32x4){0.f, 0.f, 0.f, 0.f};
        cur = nxt; cA = nA; cB = nB; ++ui;
        if constexpr (ALIGN_EPI) { if (wr == 1) PG8_BAR; }
    }
    PG8_WAIT_V(0);
    if constexpr (!ALIGN_EPI) { if (wr == 0) PG8_BAR; }
    PG8_BAR;
    if constexpr (Epi::AFTER_DRAIN) { E.fused(acc, cur, wr, wc, fr, fq, lds, wid, lane); S.done(cur); }
#undef PG8_SA
#undef PG8_SB
#undef PG8_STAGE
#undef PG8_LDA
#undef PG8_LDB
#undef PG8_MMA
#undef PG8_WAIT_V
#undef PG8_WAIT_L
#undef PG8_BAR
#undef PG8_SCHED
}
}

namespace pg8 {
typedef unsigned u32x2 __attribute__((ext_vector_type(2)));
constexpr float RMS_EPS = 1e-6f;
__device__ __forceinline__ float dot4(const f32x4 a) { return (a[0] * a[0] + a[1] * a[1]) + (a[2] * a[2] + a[3] * a[3]); }
__device__ __forceinline__ float rowsum32(const float* ssp, int row, int nsl4, int fq) {
    f32x4 v = {0.f, 0.f, 0.f, 0.f};
    if (fq < nsl4) v = *(const f32x4*)(ssp + (size_t)row * 32 + 4 * fq);
    if (fq + 4 < nsl4) v = v + *(const f32x4*)(ssp + (size_t)row * 32 + 4 * (fq + 4));
    float s = (v[0] + v[1]) + (v[2] + v[3]);
    s += __shfl_xor(s, 16); s += __shfl_xor(s, 32);
    return s;
}

struct EpiBf {
    static constexpr bool PERM = true, AFTER_DRAIN = false;
    bf16_t* O; int ldc;
    const float* ss; float inv_w; int nsl4;
    int nscale; float scale;
    float* ssA; int a_lo, a_hi; float* ssB; int b_lo, b_hi;
    int rope_lo; bf16_t* R; int ldr; int rmode;
    const float* cs; const float* sn;
    PG8_LAS float* tab; mutable int last_pm;
    __device__ __forceinline__ void operator()(const f32x4 (&acc)[2][2][4][2], const Unit& u, int wr, int wc, int fr, int fq) const {
        const int row0 = u.pm * BM + wr * 64 + fr;
        const float sc = (u.pn < nscale) ? scale : 1.f;
        float* sacc = nullptr; int slot0 = 0;
        if (u.pn >= a_lo && u.pn < a_hi) { sacc = ssA; slot0 = (u.pn - a_lo) * 4 + wc; } else if (u.pn >= b_lo && u.pn < b_hi) { sacc = ssB; slot0 = (u.pn - b_lo) * 4 + wc; }
        float rs[2][4];
        if (!ss) {
#pragma unroll
            for (int ai = 0; ai < 2; ++ai)
#pragma unroll
                for (int m = 0; m < 4; ++m) rs[ai][m] = sc;
        } else if (u.pm != last_pm) {
#pragma unroll
            for (int ai = 0; ai < 2; ++ai)
#pragma unroll
                for (int m = 0; m < 4; ++m) { const int row = row0 + ai * HALF + m * 16; const float r_ = __builtin_amdgcn_rsqf(rowsum32(ss, row, nsl4, fq) * inv_w + RMS_EPS);
                    tab[ai * HALF + wr * 64 + m * 16 + fr] = r_; rs[ai][m] = r_ * sc; }
            last_pm = u.pm;
        } else {
#pragma unroll
            for (int ai = 0; ai < 2; ++ai)
#pragma unroll
                for (int m = 0; m < 4; ++m) rs[ai][m] = tab[ai * HALF + wr * 64 + m * 16 + fr] * sc;
        }
        if (u.pn >= rope_lo) {
            const int t = u.pn - rope_lo;
#pragma unroll
            for (int ai = 0; ai < 2; ++ai)
#pragma unroll
            for (int mh = 0; mh < 2; ++mh) {
                f32x4 cc[2][2], sv[2][2];
#pragma unroll
                for (int mm = 0; mm < 2; ++mm) { const size_t ro = (size_t)(row0 + ai * HALF + (2 * mh + mm) * 16) * 32 + 8 * fq;
                    cc[mm][0] = *(const f32x4*)(cs + ro); cc[mm][1] = *(const f32x4*)(cs + ro + 4); sv[mm][0] = *(const f32x4*)(sn + ro); sv[mm][1] = *(const f32x4*)(sn + ro + 4); }
#pragma unroll
                for (int mm = 0; mm < 2; ++mm) {
                    const int m = 2 * mh + mm;
                    const int row = row0 + ai * HALF + m * 16; const float r_ = rs[ai][m];
                    const f32x4 c0 = cc[mm][0], c1 = cc[mm][1], s0 = sv[mm][0], s1 = sv[mm][1];
                    const f32x4 x10 = acc[ai][0][m][0] * r_, x11 = acc[ai][0][m][1] * r_, x20 = acc[ai][1][m][0] * r_, x21 = acc[ai][1][m][1] * r_;
                    const f32x4 o10 = x10 * c0 - x20 * s0, o11 = x11 * c1 - x21 * s1, o20 = x10 * s0 + x20 * c0, o21 = x11 * s1 + x21 * c1;
                    u32x4 w1, w2;
                    w1.x = cvt_pk_bf16(o10[0], o10[1]); w1.y = cvt_pk_bf16(o10[2], o10[3]); w1.z = cvt_pk_bf16(o11[0], o11[1]); w1.w = cvt_pk_bf16(o11[2], o11[3]);
                    w2.x = cvt_pk_bf16(o20[0], o20[1]); w2.y = cvt_pk_bf16(o20[2], o20[3]); w2.z = cvt_pk_bf16(o21[0], o21[1]); w2.w = cvt_pk_bf16(o21[2], o21[3]);
                    if (rmode == 0) { if (wc == 0) { bf16_t* p = R + (size_t)row * 64 + 8 * fq; *(u32x4*)p = w1; *(u32x4*)(p + 32) = w2; } }
                    else { bf16_t* p = R + (size_t)row * ldr + (4 * t + wc) * 64 + 8 * fq; *(u32x4*)p = w1; *(u32x4*)(p + 32) = w2; }
                }
            }
            return;
        }
#pragma unroll
        for (int ai = 0; ai < 2; ++ai)
#pragma unroll
            for (int m = 0; m < 4; ++m) {
                const int row = row0 + ai * HALF + m * 16;
                const float r_ = rs[ai][m];
                bf16_t* rowp = O + (size_t)row * ldc + u.pn * BM + wc * 32 + 8 * fq;
                float q = 0.f;
#pragma unroll
                for (int bj = 0; bj < 2; ++bj) {
                    const f32x4 v0 = acc[ai][bj][m][0] * r_, v1 = acc[ai][bj][m][1] * r_;
                    q += dot4(v0) + dot4(v1);
                    u32x4 w; w.x = cvt_pk_bf16(v0[0], v0[1]); w.y = cvt_pk_bf16(v0[2], v0[3]); w.z = cvt_pk_bf16(v1[0], v1[1]); w.w = cvt_pk_bf16(v1[2], v1[3]);
                    *(u32x4*)(rowp + bj * HALF) = w;
                }
                if (sacc) { q += __shfl_xor(q, 16); q += __shfl_xor(q, 32); if (fq == 0) sacc[(size_t)row * 32 + slot0] = q; }
            }
    }
};

typedef _Float16 f16x8v __attribute__((ext_vector_type(8)));
typedef float f32x8v __attribute__((ext_vector_type(8)));
struct EpiRes {
    static constexpr bool PERM = true, AFTER_DRAIN = false;
    const float* base32; _Float16* xh; float* ssn; int ldc; int pf;
    __device__ __forceinline__ void operator()(const f32x4 (&acc)[2][2][4][2], const Unit& u, int wr, int wc, int fr, int fq) const {
        const int row0 = u.pm * BM + wr * 64 + fr, col0 = u.pn * BM + wc * 32 + 8 * fq;
#pragma unroll
        for (int ai = 0; ai < 2; ++ai)
#pragma unroll
        for (int mh = 0; mh < 2; ++mh) {
            f32x8v pre[2][2];
            if (base32) {
#pragma unroll
                for (int mm = 0; mm < 2; ++mm) { const size_t off = (size_t)(row0 + ai * HALF + (2 * mh + mm) * 16) * ldc + col0;
#pragma unroll
                    for (int bj = 0; bj < 2; ++bj) { const f32x4 a0 = *(const f32x4*)(base32 + off + bj * HALF), a1 = *(const f32x4*)(base32 + off + bj * HALF + 4);
                        pre[mm][bj] = __builtin_shufflevector(a0, a1, 0, 1, 2, 3, 4, 5, 6, 7); } }
            } else if (pf & 1) {
#pragma unroll
                for (int mm = 0; mm < 2; ++mm)
#pragma unroll
                    for (int bj = 0; bj < 2; ++bj) pre[mm][bj] = (f32x8v){0, 0, 0, 0, 0, 0, 0, 0};
            } else {
                f16x8v ph[2][2];
#pragma unroll
                for (int mm = 0; mm < 2; ++mm) { const size_t off = (size_t)(row0 + ai * HALF + (2 * mh + mm) * 16) * ldc + col0;
#pragma unroll
                    for (int bj = 0; bj < 2; ++bj) ph[mm][bj] = *(const f16x8v*)(xh + off + bj * HALF); }
#pragma unroll
                for (int mm = 0; mm < 2; ++mm)
#pragma unroll
                    for (int bj = 0; bj < 2; ++bj) pre[mm][bj] = __builtin_convertvector(ph[mm][bj], f32x8v);
            }
#pragma unroll
            for (int mm = 0; mm < 2; ++mm) {
                const int m = 2 * mh + mm;
                const int row = row0 + ai * HALF + m * 16; const size_t off = (size_t)row * ldc + col0;
                float q = 0.f;
#pragma unroll
                for (int bj = 0; bj < 2; ++bj) {
                    const f32x8v o = pre[mm][bj] + __builtin_shufflevector(acc[ai][bj][m][0], acc[ai][bj][m][1], 0, 1, 2, 3, 4, 5, 6, 7);
                    if (!(pf & 2)) *(f16x8v*)(xh + off + bj * HALF) = __builtin_convertvector(o, f16x8v);
                    q += ((o[0] * o[0] + o[1] * o[1]) + (o[2] * o[2] + o[3] * o[3])) + ((o[4] * o[4] + o[5] * o[5]) + (o[6] * o[6] + o[7] * o[7]));
                }
                if (!(pf & 4)) { q += __shfl_xor(q, 16); q += __shfl_xor(q, 32);
                if (fq == 0) ssn[(size_t)row * 32 + u.pn * 4 + wc] = q; }
                else if (pf & 2) { if (q == 12345.678f) ssn[0] = q; }
            }
        }
    }
};

struct EpiGU {
    static constexpr bool PERM = true, AFTER_DRAIN = false;
    bf16_t* H; int ldc; const float* ss; float inv_w; PG8_LAS float* tab; mutable int last_pm;
    __device__ __forceinline__ void operator()(const f32x4 (&acc)[2][2][4][2], const Unit& u, int wr, int wc, int fr, int fq) const {
        const int row0 = u.pm * BM + wr * 64 + fr;
        float rsa[2][4];
        if (u.pm != last_pm) {
#pragma unroll
            for (int ai = 0; ai < 2; ++ai)
#pragma unroll
                for (int m = 0; m < 4; ++m) { rsa[ai][m] = __builtin_amdgcn_rsqf(rowsum32(ss, row0 + ai * HALF + m * 16, 8, fq) * inv_w + RMS_EPS); tab[ai * HALF + wr * 64 + m * 16 + fr] = rsa[ai][m]; }
            last_pm = u.pm;
        } else {
#pragma unroll
            for (int ai = 0; ai < 2; ++ai)
#pragma unroll
                for (int m = 0; m < 4; ++m) rsa[ai][m] = tab[ai * HALF + wr * 64 + m * 16 + fr];
        }
#pragma unroll
        for (int ai = 0; ai < 2; ++ai)
#pragma unroll
            for (int m = 0; m < 4; ++m) {
                const int row = row0 + ai * HALF + m * 16;
                const float rs = rsa[ai][m];
                float h[8];
#pragma unroll
                for (int n = 0; n < 2; ++n)
#pragma unroll
                    for (int e = 0; e < 4; ++e) {
                        const float g = acc[ai][0][m][n][e] * rs, uu = acc[ai][1][m][n][e] * rs;
                        const float sg = __builtin_amdgcn_rcpf(1.f + __builtin_amdgcn_exp2f(g * -1.4426950408889634f));
                        h[n * 4 + e] = g * sg * uu;
                    }
                u32x4 w; w.x = cvt_pk_bf16(h[0], h[1]); w.y = cvt_pk_bf16(h[2], h[3]); w.z = cvt_pk_bf16(h[4], h[5]); w.w = cvt_pk_bf16(h[6], h[7]);
                *(u32x4*)(H + (size_t)row * ldc + u.pn * HALF + wc * 32 + 8 * fq) = w;
            }
    }
};
}

namespace att {
typedef unsigned short bf16_t;
using bf16x8 = __attribute__((ext_vector_type(8))) short;
using s16x4  = __attribute__((ext_vector_type(4))) short;
using f32x16 = __attribute__((ext_vector_type(16))) float;
using u32x4  = __attribute__((ext_vector_type(4))) unsigned;
constexpr int NW = 8, QBLK = 32, KVBLK = 64;
constexpr int SHM_V = 16384, SHM_K = 16384, SHM_K2 = 8192;
constexpr int OFF_V = 0, OFF_K = 2 * SHM_V, OFF_WS = OFF_K + 2 * SHM_K, OFF_TB = OFF_WS + NW * 64 * 4, OFF_AUX = OFF_TB + 2048;
constexpr int OFF_K2 = OFF_AUX, OFF_Q2 = OFF_K2 + 2 * SHM_K2  , OFF_Q1 = OFF_AUX  , OFF_QH = OFF_Q2 + NW * 4096  , OFF_Q3 = OFF_QH + NW * 4096  , ATT_LDS = OFF_Q3 + NW * 1024;
constexpr int SDEPTH = 1;
constexpr float THR = 8.f;
#define KSWZ(row, colB) ((row) * 256 + ((colB) ^ (((row) & 7) << 4)))
#define K2SWZ(row, colB) ((row) * 128 + ((colB) ^ ((((row) >> 1) & 7) << 4)))
#define SBAR() __builtin_amdgcn_sched_barrier(0)
__device__ __forceinline__ int crow(int r, int hi) { return (r & 3) + 8 * (r >> 2) + 4 * hi; }
typedef float f32x2_t __attribute__((ext_vector_type(2)));
typedef __bf16 bf16x2_t __attribute__((ext_vector_type(2)));
__device__ __forceinline__ unsigned cvtpk(float lo, float hi) { f32x2_t v = {lo, hi}; bf16x2_t b = __builtin_convertvector(v, bf16x2_t); return __builtin_bit_cast(unsigned, b); }

__device__ __forceinline__ void partialSM(f32x16& p0, f32x16& p1, float& m_reg, float& mn, float& alpha) {
  float pmax = p0[0];
#pragma unroll
  for (int r = 1; r < 16; ++r) pmax = fmaxf(pmax, p0[r]);
#pragma unroll
  for (int r = 0; r < 16; ++r) pmax = fmaxf(pmax, p1[r]);
  { auto rr = __builtin_amdgcn_permlane32_swap(__float_as_uint(pmax), __float_as_uint(pmax), false, false);
    pmax = fmaxf(__uint_as_float(rr[0]), __uint_as_float(rr[1])); }
  if (__builtin_expect(__all(pmax - m_reg <= THR), 1)) { mn = m_reg; alpha = 1.f; }
  else { mn = fmaxf(m_reg, pmax); alpha = __builtin_amdgcn_exp2f(m_reg - mn); m_reg = mn; }
#pragma unroll
  for (int r = 0; r < 16; ++r) p0[r] = p0[r] - mn;
#pragma unroll
  for (int r = 0; r < 16; ++r) p1[r] = p1[r] - mn;
#pragma unroll
  for (int r = 0; r < 16; ++r) p0[r] = __builtin_amdgcn_exp2f(p0[r]);
}
__device__ __forceinline__ void finishSM(f32x16& p0, f32x16& p1, float alpha, float& l_reg, bf16x8& pa0, bf16x8& pa1, bf16x8& pa2, bf16x8& pa3) {
#pragma unroll
  for (int r = 0; r < 16; ++r) p1[r] = __builtin_amdgcn_exp2f(p1[r]);
  float ps = 0;
#pragma unroll
  for (int r = 0; r < 16; ++r) ps += p0[r];
#pragma unroll
  for (int r = 0; r < 16; ++r) ps += p1[r];
  { auto rr = __builtin_amdgcn_permlane32_swap(__float_as_uint(ps), __float_as_uint(ps), false, false);
    ps = __uint_as_float(rr[0]) + __uint_as_float(rr[1]); }
  l_reg = l_reg * alpha + ps;
#define PK4(P, BASE, OUT) do { unsigned a0 = cvtpk(P[BASE + 0], P[BASE + 1]), a1 = cvtpk(P[BASE + 2], P[BASE + 3]);   \
    unsigned b0 = cvtpk(P[BASE + 4], P[BASE + 5]), b1 = cvtpk(P[BASE + 6], P[BASE + 7]);                              \
    auto r0 = __builtin_amdgcn_permlane32_swap(a0, b0, false, false); auto r1 = __builtin_amdgcn_permlane32_swap(a1, b1, false, false); \
    u32x4 w = {r0[0], r1[0], r0[1], r1[1]}; OUT = *reinterpret_cast<bf16x8*>(&w); } while (0)
  PK4(p0, 0, pa0); PK4(p0, 8, pa1); PK4(p1, 0, pa2); PK4(p1, 8, pa3);
#undef PK4
}
#define KFRAG(d, hf) (((d) < 8) ? *reinterpret_cast<const bf16x8*>(Ks + KSWZ((hf) * 32 + r32, ((d) * 16 + hi * 8) * 2)) \
                                : *reinterpret_cast<const bf16x8*>(K2s + K2SWZ((hf) * 32 + r32, (((d) - 8) * 16 + hi * 8) * 2)))
#define QLDS(d) (((d) == 3) ? *reinterpret_cast<const bf16x8*>(Q3s) : ((d) < 8) ? *reinterpret_cast<const bf16x8*>(QHs + K2SWZ(r32, (((d) - 4) * 16 + hi * 8) * 2)) \
                           : *reinterpret_cast<const bf16x8*>(Q2s + K2SWZ(r32, (((d) - 8) * 16 + hi * 8) * 2)))
template <int MODE>
__device__ __forceinline__ void qkt(f32x16& p0, f32x16& p1, const char* Ks, const char* K2s, const bf16x8* qr, const char* Q2s, const char* QHs, const char* Q3s, int r32, int hi, bool valid) {
  if constexpr (MODE == 1) {
    if (!valid) {
#pragma unroll
      for (int r = 0; r < 16; ++r) { p0[r] = -INFINITY; p1[r] = -INFINITY; }
      return; }
    p0 = f32x16{}; p1 = f32x16{};
#pragma unroll
    for (int d0 = 0; d0 < 8; ++d0) { const int cb = (d0 * 16 + hi * 8) * 2;
      bf16x8 b0 = *reinterpret_cast<const bf16x8*>(Ks + KSWZ(r32, cb));
      bf16x8 b1 = *reinterpret_cast<const bf16x8*>(Ks + KSWZ(32 + r32, cb));
      bf16x8 qf = *reinterpret_cast<const bf16x8*>(Q2s + KSWZ(r32, cb));
      p0 = __builtin_amdgcn_mfma_f32_32x32x16_bf16(b0, qf, p0, 0, 0, 0);
      p1 = __builtin_amdgcn_mfma_f32_32x32x16_bf16(b1, qf, p1, 0, 0, 0); }
  } else {
    p0 = f32x16{}; p1 = f32x16{};
    constexpr int ND = (MODE == 2) ? 12 : 8;
    bf16x8 ka[2], kb[2];
    ka[0] = KFRAG(0, 0); kb[0] = KFRAG(0, 1);
#pragma unroll
    for (int d = 0; d < ND; ++d) {
      bf16x8 q; if (MODE == 2 && d >= 3) q = QLDS(d); else q = qr[d < 8 ? d : 0];
      if (d + 1 < ND) { ka[(d + 1) & 1] = KFRAG(d + 1, 0); kb[(d + 1) & 1] = KFRAG(d + 1, 1); }
      p0 = __builtin_amdgcn_mfma_f32_32x32x16_bf16(ka[d & 1], q, p0, 0, 0, 0);
      p1 = __builtin_amdgcn_mfma_f32_32x32x16_bf16(kb[d & 1], q, p1, 0, 0, 0);
    }
    __builtin_amdgcn_sched_group_barrier(0x100, 2, 0);
#pragma unroll
    for (int d = 0; d < ND; ++d) {
      { const int nrd = ((MODE == 2 && d >= 3) ? 1 : 0) + ((d + 1 < ND) ? 2 : 0);
        if (nrd == 3) __builtin_amdgcn_sched_group_barrier(0x100, 3, 0); else if (nrd == 2) __builtin_amdgcn_sched_group_barrier(0x100, 2, 0); else if (nrd == 1) __builtin_amdgcn_sched_group_barrier(0x100, 1, 0); }
      __builtin_amdgcn_sched_group_barrier(0x008, 2, 0);
    }
    if constexpr (MODE == 2) {
      const float msk = valid ? 0.f : -INFINITY;
#pragma unroll
      for (int r = 0; r < 16; ++r) { p0[r] = valid ? p0[r] : msk; p1[r] = valid ? p1[r] : msk; }
    }
  }
}
#undef KFRAG
#undef QLDS
__device__ __forceinline__ void add_bias(f32x16& p0, f32x16& p1, const float* tb, int rel0, bool far) {
  if (far) { const float c = tb[256];
#pragma unroll
    for (int r = 0; r < 16; ++r) { p0[r] += c; p1[r] += c; }
  } else {
#pragma unroll
    for (int r = 0; r < 16; ++r) { const int kk = (r & 3) + 8 * (r >> 2);
      int i0 = rel0 - kk; i0 = i0 > 128 ? 128 : i0;
      int i1 = rel0 - 32 - kk; i1 = i1 > 128 ? 128 : i1;
      p0[r] += tb[i0 + 128]; p1[r] += tb[i1 + 128];
      if ((r & 1) == 1) SBAR(); }
  }
}
__device__ __forceinline__ int v_st(int k, int c) { const int kk = (k & ~0xC) | ((k & 4) << 1) | ((k & 8) >> 1); return ((kk >> 3) * 4 + (c >> 5)) * 512 + ((kk & 7) * 32 + (c & 31)) * 2; }
__device__ __forceinline__ int v_rd_base(int lane) { return ((lane & 3) << 3) | (((lane >> 2) & 3) << 6) | (((lane >> 4) & 1) << 5) | (((lane >> 5) & 1) << 8); }
constexpr int v_rd_off(int d0, int ks, int half) { return d0 * 512 + ks * 4096 + half * 2048; }
template <int OFF> __device__ __forceinline__ s16x4 tr_read(int vb) {
  s16x4 r; asm volatile("ds_read_b64_tr_b16 %0, %1 offset:%2" : "=&v"(r) : "v"(vb), "i"(OFF) : "memory"); return r;
}
template <int D0> __device__ __forceinline__ void pv_one(f32x16& od, int vb, bf16x8 pa0, bf16x8 pa1, bf16x8 pa2, bf16x8 pa3) {
  const s16x4 l0 = tr_read<v_rd_off(D0, 0, 0)>(vb), h0 = tr_read<v_rd_off(D0, 0, 1)>(vb), l1 = tr_read<v_rd_off(D0, 1, 0)>(vb), h1 = tr_read<v_rd_off(D0, 1, 1)>(vb);
  const s16x4 l2 = tr_read<v_rd_off(D0, 2, 0)>(vb), h2 = tr_read<v_rd_off(D0, 2, 1)>(vb), l3 = tr_read<v_rd_off(D0, 3, 0)>(vb), h3 = tr_read<v_rd_off(D0, 3, 1)>(vb);
  asm volatile("s_waitcnt lgkmcnt(0)" ::: "memory"); SBAR();
#define PK(L, H) (bf16x8){L[0], L[1], L[2], L[3], H[0], H[1], H[2], H[3]}
  od = __builtin_amdgcn_mfma_f32_32x32x16_bf16(pa0, PK(l0, h0), od, 0, 0, 0);
  od = __builtin_amdgcn_mfma_f32_32x32x16_bf16(pa1, PK(l1, h1), od, 0, 0, 0);
  od = __builtin_amdgcn_mfma_f32_32x32x16_bf16(pa2, PK(l2, h2), od, 0, 0, 0);
  od = __builtin_amdgcn_mfma_f32_32x32x16_bf16(pa3, PK(l3, h3), od, 0, 0, 0);
#undef PK
}
__device__ __forceinline__ void pv_d0(f32x16* o, int vb, bf16x8 pa0, bf16x8 pa1, bf16x8 pa2, bf16x8 pa3) {
  pv_one<0>(o[0], vb, pa0, pa1, pa2, pa3); pv_one<1>(o[1], vb, pa0, pa1, pa2, pa3); pv_one<2>(o[2], vb, pa0, pa1, pa2, pa3); pv_one<3>(o[3], vb, pa0, pa1, pa2, pa3);
}

template <int MODE>
__device__ __forceinline__ void attn_unit(char* lds, const bf16_t* __restrict__ Qb, const bf16_t* __restrict__ Q2b, const bf16_t* __restrict__ Kh, const bf16_t* __restrict__ Vh,
                                          const bf16_t* __restrict__ K2h, bf16_t* __restrict__ Ob, int ldq, int ldq2, int ldk, int ldo, int NT, int qc0, int kc0, const float* __restrict__ bias_g) {
  int tid = threadIdx.x; asm volatile("" : "+v"(tid));
  const int wid = __builtin_amdgcn_readfirstlane(tid >> 6), lane = tid & 63, r32 = lane & 31, hi = lane >> 5;
  char* V_lds = lds + OFF_V; char* K_lds = lds + OFF_K; char* K2_lds = lds + OFF_K2;
  float* ws = (float*)(lds + OFF_WS) + wid * 64; float* li_l = ws; float* al_l = ws + 32;
  float* tb = (float*)(lds + OFF_TB);
  int jlo = 0, jhi = NT - 1;
  if constexpr (MODE == 1) { const int cq = qc0 + (wid >> 1); jlo = (cq - 8 > 0 ? cq - 8 : 0) - kc0; jhi = cq - kc0; }
  if constexpr (MODE == 2) { jhi = qc0 + (wid >> 1) - kc0; }
  if constexpr (MODE == 1) { if (tid < 257) tb[tid] = bias_g[tid] * 1.4426950408889634f; }
  float m_reg = -1e30f, l_reg = 0; f32x16 o[4] = {}; bf16x8 qr[8];
  char* Q2s = (MODE == 1) ? lds + OFF_Q1 + wid * 8192 : lds + OFF_Q2 + wid * 4096;
  char* QHs = lds + OFF_QH + wid * 4096; char* Q3s = lds + OFF_Q3 + wid * 1024 + lane * 16;
  const bf16_t* Qw = Qb + (long)(wid * QBLK + r32) * ldq + hi * 8;
  if constexpr (MODE == 1) {
#pragma unroll
    for (int d0 = 0; d0 < 8; ++d0) *reinterpret_cast<bf16x8*>(Q2s + KSWZ(r32, (d0 * 16 + hi * 8) * 2)) = *reinterpret_cast<const bf16x8*>(Qw + d0 * 16);
    asm volatile("s_waitcnt lgkmcnt(0)" ::: "memory");
  } else if constexpr (MODE == 2) {
#pragma unroll
    for (int d0 = 0; d0 < 3; ++d0) qr[d0] = *reinterpret_cast<const bf16x8*>(Qw + d0 * 16);
    *reinterpret_cast<bf16x8*>(Q3s) = *reinterpret_cast<const bf16x8*>(Qw + 3 * 16);
#pragma unroll
    for (int d0 = 4; d0 < 8; ++d0) *reinterpret_cast<bf16x8*>(QHs + K2SWZ(r32, ((d0 - 4) * 16 + hi * 8) * 2)) = *reinterpret_cast<const bf16x8*>(Qw + d0 * 16);
    asm volatile("s_waitcnt lgkmcnt(0)" ::: "memory");
  } else {
#pragma unroll
    for (int d0 = 0; d0 < 8; ++d0) qr[d0] = *reinterpret_cast<const bf16x8*>(Qw + d0 * 16);
  }
  if constexpr (MODE == 2) { const bf16_t* Q2w = Q2b + (long)(wid * QBLK + r32) * ldq2 + hi * 8;
#pragma unroll
    for (int d0 = 0; d0 < 4; ++d0) *reinterpret_cast<bf16x8*>(Q2s + K2SWZ(r32, (d0 * 16 + hi * 8) * 2)) = *reinterpret_cast<const bf16x8*>(Q2w + d0 * 16);
    asm volatile("s_waitcnt lgkmcnt(0)" ::: "memory"); }
  const int sr = tid >> 4, sc = (tid & 15) * 8, vst0 = v_st(sr, sc), vst1 = v_st(32 + sr, sc);
  const int s2r = tid >> 3, s2c = (tid & 7) * 8;
  const int vb0 = (int)(uintptr_t)V_lds + v_rd_base(lane);
  const int relq = (qc0 - kc0) * 64 + wid * 32 + r32 - 4 * hi;
  struct { bf16x8 vs0, vs1, ks0, ks1, k2; } sr_[SDEPTH];
#define SLOAD(i, jt) do { const long k0_ = (long)(jt) * KVBLK; sr_[i].vs0 = *reinterpret_cast<const bf16x8*>(&Vh[(k0_ + sr) * ldk + sc]); sr_[i].vs1 = *reinterpret_cast<const bf16x8*>(&Vh[(k0_ + 32 + sr) * ldk + sc]); \
    sr_[i].ks0 = *reinterpret_cast<const bf16x8*>(&Kh[(k0_ + sr) * ldk + sc]); sr_[i].ks1 = *reinterpret_cast<const bf16x8*>(&Kh[(k0_ + 32 + sr) * ldk + sc]); \
    if constexpr (MODE == 2) sr_[i].k2 = *reinterpret_cast<const bf16x8*>(&K2h[(k0_ + s2r) * 64 + s2c]); } while (0)
#define SWRITE(b, i) do { *(bf16x8*)(V_lds + (b) * SHM_V + vst0) = sr_[i].vs0;          \
    *(bf16x8*)(V_lds + (b) * SHM_V + vst1) = sr_[i].vs1; const int kc_ = sc * 2;               \
    *(bf16x8*)(K_lds + (b) * SHM_K + KSWZ(sr, kc_)) = sr_[i].ks0;                       \
    *(bf16x8*)(K_lds + (b) * SHM_K + KSWZ(32 + sr, kc_)) = sr_[i].ks1; \
    if constexpr (MODE == 2) *(bf16x8*)(K2_lds + (b) * SHM_K2 + K2SWZ(s2r, s2c * 2)) = sr_[i].k2; } while (0)
#define SWAIT() do { if constexpr (SDEPTH == 1) asm volatile("s_waitcnt vmcnt(0)" ::: "memory"); else if constexpr (MODE == 2) asm volatile("s_waitcnt vmcnt(5)" ::: "memory"); else asm volatile("s_waitcnt vmcnt(4)" ::: "memory"); } while (0)
#define RESC(a) do { if (__any((a) < 1.f)) { if (hi == 0) al_l[r32] = (a); asm volatile("s_waitcnt lgkmcnt(0)" ::: "memory"); \
    _Pragma("unroll") for (int d = 0; d < 4; ++d) _Pragma("unroll") for (int r = 0; r < 16; ++r) o[d][r] *= al_l[crow(r, hi)]; } } while (0)
#define VALID(j) ((j) >= jlo && (j) <= jhi)
#define QKT(P0, P1, b, j) do { const bool v_ = VALID(j); qkt<MODE>(P0, P1, K_lds + (b) * SHM_K, K2_lds + (b) * SHM_K2, qr, Q2s, QHs, Q3s, r32, hi, v_); \
    if constexpr (MODE == 1) { if (v_) { const bool far_ = ((qc0 - kc0) * 64 + wid * 32 - (j) * 64 - 63) >= 128; add_bias(P0, P1, tb, relq - (j) * 64, far_); } } } while (0)
  f32x16 pA0, pA1, pB0, pB1; float mnA, mnB, alA, alB; bf16x8 pa0, pa1, pa2, pa3;
  constexpr int SE = 0, SO = SDEPTH - 1;
  SLOAD(SE, 0); asm volatile("s_waitcnt vmcnt(0)" ::: "memory"); SWRITE(0, SE); __syncthreads();
  QKT(pA0, pA1, 0, 0); partialSM(pA0, pA1, m_reg, mnA, alA);
  SLOAD(SO, 1); if constexpr (SDEPTH == 2) { if (2 < NT) SLOAD(SE, 2); }
  SWAIT(); SWRITE(1, SO); __syncthreads();
  for (int j = 1; j + 1 < NT; j += 2) {
    SBAR(); QKT(pB0, pB1, 1, j);
    finishSM(pA0, pA1, alA, l_reg, pa0, pa1, pa2, pa3); SBAR();
    SLOAD(SO, j + SDEPTH); SBAR();
    if (MODE != 1 || VALID(j - 1)) pv_d0(o, vb0, pa0, pa1, pa2, pa3);
    partialSM(pB0, pB1, m_reg, mnB, alB);
    __syncthreads(); SWAIT(); SWRITE(0, SE);
    RESC(alB); __syncthreads();
    SBAR(); QKT(pA0, pA1, 0, j + 1);
    finishSM(pB0, pB1, alB, l_reg, pa0, pa1, pa2, pa3); SBAR();
    if (SDEPTH == 1 || j + 3 < NT) SLOAD(SE, j + 1 + SDEPTH); SBAR();
    if (MODE != 1 || VALID(j)) pv_d0(o, vb0 + SHM_V, pa0, pa1, pa2, pa3);
    partialSM(pA0, pA1, m_reg, mnA, alA);
    __syncthreads(); SWAIT(); SWRITE(1, SO);
    RESC(alA); __syncthreads();
  }
  SBAR(); QKT(pB0, pB1, 1, NT - 1);
  finishSM(pA0, pA1, alA, l_reg, pa0, pa1, pa2, pa3); SBAR();
  if (MODE != 1 || VALID(NT - 2)) pv_d0(o, vb0, pa0, pa1, pa2, pa3);
  partialSM(pB0, pB1, m_reg, mnB, alB);
  __syncthreads(); RESC(alB);
  finishSM(pB0, pB1, alB, l_reg, pa0, pa1, pa2, pa3); SBAR();
  if (MODE != 1 || VALID(NT - 1)) pv_d0(o, vb0 + SHM_V, pa0, pa1, pa2, pa3);
  if (hi == 0) li_l[r32] = l_reg; asm volatile("s_waitcnt lgkmcnt(0)" ::: "memory");
  float rli[16];
#pragma unroll
  for (int r = 0; r < 16; ++r) rli[r] = __builtin_amdgcn_rcpf(li_l[crow(r, hi)]);
  bf16_t* Ow = Ob + (long)(wid * QBLK) * ldo;
#pragma unroll
  for (int r = 0; r < 16; ++r) { const int orow = crow(r, hi);
#pragma unroll
    for (int d0 = 0; d0 < 4; ++d0) Ow[(long)orow * ldo + d0 * 32 + r32] = (bf16_t)(cvtpk(o[d0][r] * rli[r], 0.f) & 0xffffu); }
  __syncthreads();
#undef SLOAD
#undef SWRITE
#undef SWAIT
#undef RESC
#undef VALID
#undef QKT
}
}

#define LAS __attribute__((address_space(3)))
typedef unsigned short bf16;
typedef unsigned v4u __attribute__((ext_vector_type(4)));
typedef float f32x4 __attribute__((ext_vector_type(4)));

constexpr int BATCH = 4, SEQ = 4096, M = BATCH * SEQ, DM = 2048, DEPTH = 4;
constexpr int INW = 4416, INP = 4608, QW = 1536, KVW = 2048, DFF = 5632, NMEM = 256, XW = 512;
constexpr float EPS = 1e-6f, LOG2E = 1.4426950408889634f;
constexpr size_t MiB = 1u << 20;
constexpr size_t WS_COS = 2 * MiB, WS_SIN = 4 * MiB, WS_MEMN = 6 * MiB, WS_MEMKV = 10 * MiB, WS_KR = 18 * MiB, WS_WXKV = 20 * MiB;
constexpr size_t WS_W = 36 * MiB, W_LAYER = 101 * MiB;
constexpr size_t WO_IN = 0, WO_UQ = 18 * MiB, WO_UKV = 21 * MiB, WO_OUT = 23 * MiB, WO_XQ = 31 * MiB, WO_XO = 33 * MiB, WO_GU = 35 * MiB, WO_D = 79 * MiB;
constexpr size_t WS_XB = 440 * MiB, WS_PROJ = 504 * MiB, WS_QB = 648 * MiB, WS_KVB = 696 * MiB, WS_OB = 760 * MiB, WS_QX = 824 * MiB, WS_OX = 840 * MiB, WS_SS = 856 * MiB, WS_BAR = 898 * MiB, WS_END = 899 * MiB;
constexpr size_t WS_HFF = WS_PROJ;
static_assert(WS_HFF + (size_t)M * DFF * 2 <= WS_KVB, "HFF overlay");
constexpr int SS_MIX = 0, SS_MEM = 1, SS_FFN = 2, SS_FINAL = 12, SS_Q = 13, SS_KV = 17, SS_NBUF = 21;
constexpr int LDS_BYTES = 163840, LDS_BARST = LDS_BYTES - 64, LDS_RSTAB = 159744;
static_assert(att::ATT_LDS <= LDS_RSTAB && LDS_RSTAB + 1024 <= LDS_BARST, "LDS map");
constexpr int NWAVES = 8;

__device__ const float ROPE_INV[32] = {1.000000000e+00f, 7.498942018e-01f, 5.623413324e-01f, 4.216965139e-01f, 3.162277639e-01f, 2.371373773e-01f, 1.778279394e-01f, 1.333521456e-01f, 1.000000015e-01f, 7.498942316e-02f, 5.623413250e-02f, 4.216964915e-02f, 3.162277490e-02f, 2.371373773e-02f, 1.778279431e-02f, 1.333521400e-02f, 9.999999776e-03f, 7.498942316e-03f, 5.623413250e-03f, 4.216964822e-03f, 3.162277630e-03f, 2.371373819e-03f, 1.778279431e-03f, 1.333521446e-03f, 1.000000047e-03f, 7.498941850e-04f, 5.623413017e-04f, 4.216965172e-04f, 3.162277571e-04f, 2.371373703e-04f, 1.778279402e-04f, 1.333521504e-04f};

__device__ __forceinline__ unsigned f2bf(float f) { unsigned u = __builtin_bit_cast(unsigned, f); return (u + 0x7fffu + ((u >> 16) & 1u)) >> 16; }
__device__ __forceinline__ unsigned pk2(float lo, float hi) { return f2bf(lo) | (f2bf(hi) << 16); }
typedef _Float16 h2_t __attribute__((ext_vector_type(2)));
__device__ __forceinline__ unsigned pkh2(float lo, float hi) { h2_t v = {(_Float16)lo, (_Float16)hi}; return __builtin_bit_cast(unsigned, v); }
__device__ __forceinline__ float wave_sum(float v) {
#pragma unroll
    for (int o = 1; o < 64; o <<= 1) v += __shfl_xor(v, o);
    return v;
}
#define LDS_WAIT() asm volatile("s_waitcnt lgkmcnt(0)" ::: "memory")

struct Args { const void* in[21]; float* out; unsigned char* ws; };

__device__ __forceinline__ void tr_item(const float* __restrict__ W, int ldw, int srccol, int k0, const float* __restrict__ gain, bf16* __restrict__ WT, int K, int dstrow0, LAS float* scr, int lane, bool f16 = false) {
    if (srccol >= 0) {
        float v[32];
        const float* wp = W + (size_t)(k0 + (lane >> 5)) * ldw + srccol + (lane & 31);
#pragma unroll
        for (int i = 0; i < 32; ++i) v[i] = wp[(size_t)(2 * i) * ldw];
        if (gain) {
            const float* gp = gain + k0 + (lane >> 5);
#pragma unroll
            for (int i = 0; i < 32; ++i) v[i] *= gp[2 * i];
        }
#pragma unroll
        for (int i = 0; i < 32; ++i) scr[(2 * i + (lane >> 5)) * 33 + (lane & 31)] = v[i];
    } else {
#pragma unroll 8
        for (int i = 0; i < 32; ++i) { const int kk = 2 * i + (lane >> 5); scr[kk * 33 + (lane & 31)] = 0.f; }
    }
    LDS_WAIT(); asm volatile("" ::: "memory");
    const int c = lane & 7;
#pragma unroll
    for (int j = 0; j < 4; ++j) { const int n = (lane >> 3) + 8 * j; const LAS float* s = scr + (8 * c) * 33 + n;
        v4u o; if (f16) { o.x = pkh2(s[0 * 33], s[1 * 33]); o.y = pkh2(s[2 * 33], s[3 * 33]); o.z = pkh2(s[4 * 33], s[5 * 33]); o.w = pkh2(s[6 * 33], s[7 * 33]); }
        else { o.x = pk2(s[0 * 33], s[1 * 33]); o.y = pk2(s[2 * 33], s[3 * 33]); o.z = pk2(s[4 * 33], s[5 * 33]); o.w = pk2(s[6 * 33], s[7 * 33]); }
        *(v4u*)(WT + (size_t)(dstrow0 + n) * K + k0 + 8 * c) = o; }
    LDS_WAIT(); asm volatile("" ::: "memory");
}

constexpr int IT_IN = 32 * 144, IT_UQ = 12 * 48, IT_UKV = 8 * 64, IT_OUT = 32 * 64, IT_XQ = 32 * 16, IT_XKV = 32 * 32, IT_XO = 8 * 64, IT_GU = 32 * 352, IT_D = 88 * 64;
constexpr int IT_LAYER = IT_IN + IT_UQ + IT_UKV + IT_OUT + IT_XQ + IT_XKV + IT_XO + IT_GU + IT_D;

__device__ __forceinline__ void convert_item(const Args& a, unsigned char* ws, int l, int rp, LAS float* scr, int lane) {
        constexpr int R_OUT0 = IT_IN + IT_UQ + IT_UKV, R_XKV0 = R_OUT0 + IT_OUT + IT_XQ, R_XO0 = R_XKV0 + IT_XKV;
        int r = rp;
        if (rp >= R_OUT0 && rp < R_OUT0 + IT_XKV) r = rp - R_OUT0 + R_XKV0;
        else if (rp >= R_OUT0 + IT_XKV && rp < R_XO0) r = rp - IT_XKV;
        unsigned char* wl = ws + WS_W + (size_t)l * W_LAYER;
        if (r < IT_IN) { const int nblk = INP / 32, kb = r / nblk, nb = r % nblk, n0 = nb * 32; int src = n0;
            if (n0 >= 4352) { const int j = n0 - 4352; src = (j == 0) ? 4352 : (j == 128 ? 4384 : -1); }
            tr_item((const float*)a.in[4] + (size_t)l * DM * INW, INW, src, kb * 64, (const float*)a.in[3] + l * DM, (bf16*)(wl + WO_IN), DM, n0, scr, lane, true); return; }
        r -= IT_IN;
        if (r < IT_UQ) { const int nblk = QW / 32, kb = r / nblk, nb = r % nblk, n0 = nb * 32; int src;
            if (n0 < 1024) src = (n0 >> 7) * 192 + (n0 & 127);
            else { const int rr = n0 - 1024, t = rr >> 8, j = rr & 255, bj = j >> 7, hl = (j & 127) >> 5; src = (4 * t + hl) * 192 + 128 + 32 * bj; }
            tr_item((const float*)a.in[8] + (size_t)l * 768 * QW, QW, src, kb * 64, (const float*)a.in[6] + l * 768, (bf16*)(wl + WO_UQ), 768, n0, scr, lane); return; }
        r -= IT_UQ;
        if (r < IT_UKV) { const int nblk = KVW / 32, kb = r / nblk, nb = r % nblk, n0 = nb * 32;
            const int src = (n0 < 1024) ? (n0 >> 7) * 256 + (n0 & 127) : ((n0 - 1024) >> 7) * 256 + 128 + (n0 & 127);
            tr_item((const float*)a.in[9] + (size_t)l * 512 * KVW, KVW, src, kb * 64, (const float*)a.in[7] + l * 512, (bf16*)(wl + WO_UKV), 512, n0, scr, lane); return; }
        r -= IT_UKV;
        if (r < IT_OUT) { const int nblk = DM / 32, kb = r / nblk, nb = r % nblk, n0 = nb * 32;
            tr_item((const float*)a.in[10] + (size_t)l * DM * DM, DM, n0, kb * 64, nullptr, (bf16*)(wl + WO_OUT), DM, n0, scr, lane); return; }
        r -= IT_OUT;
        if (r < IT_XQ) { const int nblk = XW / 32, kb = r / nblk, nb = r % nblk, n0 = nb * 32;
            tr_item((const float*)a.in[13] + (size_t)l * DM * XW, XW, n0, kb * 64, (const float*)a.in[11] + l * DM, (bf16*)(wl + WO_XQ), DM, n0, scr, lane, true); return; }
        r -= IT_XQ;
        if (r < IT_XKV) { const int nblk = 1024 / 32, kb = r / nblk, nb = r % nblk, n0 = nb * 32;
            tr_item((const float*)a.in[14] + (size_t)l * DM * 1024, 1024, n0, kb * 64, nullptr, (bf16*)(ws + WS_WXKV), DM, l * 1024 + n0, scr, lane); return; }
        r -= IT_XKV;
        if (r < IT_XO) { const int nblk = DM / 32, kb = r / nblk, nb = r % nblk, n0 = nb * 32;
            tr_item((const float*)a.in[15] + (size_t)l * XW * DM, DM, n0, kb * 64, nullptr, (bf16*)(wl + WO_XO), XW, n0, scr, lane); return; }
        r -= IT_XO;
        if (r < IT_GU) { const int nblk = 2 * DFF / 32, kb = r / nblk, nb = r % nblk, n0 = nb * 32; const int t = n0 >> 8, j = n0 & 255;
            const float* Wsrc = (const float*)a.in[j < 128 ? 17 : 18] + (size_t)l * DM * DFF;
            tr_item(Wsrc, DFF, t * 128 + (j & 127), kb * 64, (const float*)a.in[16] + l * DM, (bf16*)(wl + WO_GU), DM, n0, scr, lane, true); return; }
        r -= IT_GU;
        { const int nblk = DM / 32, kb = r / nblk, nb = r % nblk, n0 = nb * 32;
            tr_item((const float*)a.in[19] + (size_t)l * DFF * DM, DM, n0, kb * 64, nullptr, (bf16*)(wl + WO_D), DFF, n0, scr, lane); }
}
#ifndef SLOT_EXTRA
#define SLOT_EXTRA 0
#endif
#ifndef SLOT_A
#define SLOT_A 10560
#endif
#ifndef SLOT_D
#define SLOT_D 3000
#endif
constexpr int IT_EARLY = IT_IN + IT_UQ + IT_UKV + IT_XKV + SLOT_EXTRA;
constexpr int IT_SLOT_A = IT_EARLY + SLOT_A, IT_SLOT_D = IT_SLOT_A + SLOT_D;
__device__ __forceinline__ void convert_range(const Args& a, LAS unsigned char* lds, int l, int r_lo, int r_hi) {
    int tid = threadIdx.x; asm volatile("" : "+v"(tid));
    const int lane = tid & 63, wave = __builtin_amdgcn_readfirstlane(tid >> 6);
    const int G = gridDim.x, first = G / 2, nidle = G - first;
    LAS float* scr = (LAS float*)(lds + wave * 16384);
    for (int r = r_lo + ((int)blockIdx.x - first) * NWAVES + wave; r < r_hi; r += nidle * NWAVES) convert_item(a, a.ws, l, r, scr, lane);
}

__device__ __forceinline__ void prologue(const Args& a, LAS unsigned char* lds) {
    int tid = threadIdx.x; asm volatile("" : "+v"(tid));
    const int lane = tid & 63, wave = __builtin_amdgcn_readfirstlane(tid >> 6);
    const int G = gridDim.x, gw = blockIdx.x * NWAVES + wave, NGW = G * NWAVES;
    unsigned char* ws = a.ws;
    LAS float* scr = (LAS float*)(lds + wave * 16384);
    for (int it = gw; it < DEPTH * IT_EARLY; it += NGW) convert_item(a, ws, it / IT_EARLY, it % IT_EARLY, scr, lane);
    float* ss = (float*)(ws + WS_SS);
    for (int m = gw; m < M + BATCH * NMEM; m += NGW) {
        const bool is_x = m < M; const int row = is_x ? m : m - M;
        const f32x4* xr = (const f32x4*)((const float*)(is_x ? a.in[0] : a.in[1]) + (size_t)row * DM) + lane;
        f32x4 v[8]; float s = 0.f;
#pragma unroll
        for (int j = 0; j < 8; ++j) { v[j] = xr[64 * j]; s += (v[j][0] * v[j][0] + v[j][1] * v[j][1]) + (v[j][2] * v[j][2] + v[j][3] * v[j][3]); }
        s = wave_sum(s);
        unsigned long long* o8 = (unsigned long long*)((bf16*)(ws + (is_x ? WS_XB : WS_MEMN)) + (size_t)row * DM) + lane;
        if (is_x) { if (lane < 32) ss[(size_t)row * 32 + lane] = (lane == 0) ? s : 0.f;
#pragma unroll
            for (int j = 0; j < 8; ++j) o8[64 * j] = (unsigned long long)pkh2(v[j][0], v[j][1]) | ((unsigned long long)pkh2(v[j][2], v[j][3]) << 32);
        } else { const float rstd = 1.f / sqrtf(s * (1.f / DM) + EPS); const f32x4* gr = (const f32x4*)a.in[12] + lane;
#pragma unroll
            for (int j = 0; j < 8; ++j) { const f32x4 g = gr[64 * j]; o8[64 * j] = (unsigned long long)pk2(v[j][0] * rstd * g[0], v[j][1] * rstd * g[1]) | ((unsigned long long)pk2(v[j][2] * rstd * g[2], v[j][3] * rstd * g[3]) << 32); }
        }
    }
    const int gt = blockIdx.x * (NWAVES * 64) + tid, NGT = G * NWAVES * 64;
    float* cs = (float*)(ws + WS_COS); float* sn = (float*)(ws + WS_SIN); const int* pos = (const int*)a.in[2];
    for (int i = gt; i < M * 32; i += NGT) {
        const float ang = (float)pos[i >> 5] * ROPE_INV[i & 31];
        double t = (double)ang * 0.15915494309189535; t -= __builtin_rint(t);
        cs[i] = __builtin_amdgcn_cosf((float)t); sn[i] = __builtin_amdgcn_sinf((float)t);
    }
}

#define XB_TMO      128
#define XB_XCNT(j)  (256  + 64 * (j))
#define XB_XSUB(j)  (1280 + 64 * (j))
#define XB_XGEN(j)  (2304 + 64 * (j))
#define XB_TOP      3328
#define XB_TOPGEN   3392
#define XCD_BAR_WORDS 3456
#define XB_SPIN_CAP (1u << 18)

__device__ __forceinline__ unsigned xb_ld(unsigned* p)              { return __hip_atomic_load(p, __ATOMIC_RELAXED, __HIP_MEMORY_SCOPE_AGENT); }
__device__ __forceinline__ unsigned xb_add(unsigned* p, unsigned v) { return __hip_atomic_fetch_add(p, v, __ATOMIC_RELAXED, __HIP_MEMORY_SCOPE_AGENT); }
__device__ __forceinline__ unsigned xb_xcc_id() { return (unsigned)__builtin_amdgcn_s_getreg((3 << 11) | 20) & 0xFu; }
#define XB_SPIN(cond, bar) do { unsigned _sp = 0; while (cond) { __builtin_amdgcn_s_sleep(1); \
    if ((++_sp & 255u) == 0u) { if (xb_ld(&(bar)[XB_TMO])) break; if (_sp > XB_SPIN_CAP) { atomicAdd(&(bar)[XB_TMO], 1u); break; } } } } while (0)

struct XcdBarrier {
    unsigned* bar; unsigned x;
    volatile LAS unsigned* st;
};

__device__ __forceinline__ XcdBarrier xcd_barrier_post(unsigned* bar, volatile LAS unsigned* st) {
    XcdBarrier b; b.bar = bar; b.x = xb_xcc_id(); b.st = st;
    if (threadIdx.x == 0) (void)xb_add(&bar[XB_XCNT(b.x)], 1u);
    return b;
}
__device__ __forceinline__ void xcd_barrier_complete(unsigned* bar, unsigned x, unsigned& nloc, unsigned& nx) {
    const unsigned G = gridDim.x * gridDim.y * gridDim.z;
    unsigned sum, cnt, mine, sp = 0u;
    for (;;) {
        sum = 0u; cnt = 0u; mine = 0u;
#pragma unroll
        for (unsigned j = 0; j < 16; ++j) { const unsigned c = xb_ld(&bar[XB_XCNT(j)]); sum += c; cnt += (c > 0u) ? 1u : 0u; mine = (j == x) ? c : mine; }
        if (sum == G) break;
        __builtin_amdgcn_s_sleep(1);
        if ((++sp & 255u) == 0u) { if (xb_ld(&bar[XB_TMO])) break; if (sp > XB_SPIN_CAP) { atomicAdd(&bar[XB_TMO], 1u); break; } }
    }
    nloc = mine > 0u ? mine : 1u; nx = cnt > 0u ? cnt : 1u;
}

__device__ __forceinline__ void xcd_barrier(const XcdBarrier& b) {
    asm volatile("s_waitcnt vmcnt(0)" ::: "memory");
    __syncthreads();
    if (threadIdx.x == 0) {
        unsigned* bar = b.bar;
        __builtin_amdgcn_s_waitcnt(0);
        unsigned nloc = b.st[0], nx = b.st[1];
        if (nloc == 0u) { xcd_barrier_complete(bar, b.x, nloc, nx); b.st[0] = nloc; b.st[1] = nx; }
        const unsigned old = xb_add(&bar[XB_XSUB(b.x)], 1u);
        const unsigned gen = old / nloc;
        if (old + 1u == (gen + 1u) * nloc) {
            __builtin_amdgcn_fence(__ATOMIC_RELEASE, "agent");
            asm volatile("s_waitcnt vmcnt(0)" ::: "memory");
            const unsigned og = xb_add(&bar[XB_TOP], 1u);
            const unsigned tg = og / nx;
            if (og + 1u == (tg + 1u) * nx) xb_add(&bar[XB_TOPGEN], 1u);
            else XB_SPIN(xb_ld(&bar[XB_TOPGEN]) == tg, bar);
            __builtin_amdgcn_fence(__ATOMIC_ACQUIRE, "agent");
            xb_add(&bar[XB_XGEN(b.x)], 1u);
            asm volatile("s_waitcnt vmcnt(0)" ::: "memory");
        } else {
            XB_SPIN(xb_ld(&bar[XB_XGEN(b.x)]) == gen, bar);
            __builtin_amdgcn_fence(__ATOMIC_ACQUIRE, "agent");
            asm volatile("s_waitcnt vmcnt(0)" ::: "memory");
        }
    }
    __syncthreads();
}

__device__ __forceinline__ void attn_mix_phase(const Args& a, char* lds, int l, int skip = 0) {
    unsigned char* ws = a.ws;
    const bf16* PROJ = (const bf16*)(ws + WS_PROJ); const bf16* QB = (const bf16*)(ws + WS_QB); const bf16* KVB = (const bf16*)(ws + WS_KVB); const bf16* KR = (const bf16*)(ws + WS_KR);
    bf16* OB = (bf16*)(ws + WS_OB);
#pragma unroll 1
    for (int ui = blockIdx.x; ui < 1024; ui += gridDim.x) {
        if ((skip == 1 && ui < 512) || (skip == 2 && ui >= 512)) continue;
        if (ui < 512) {
            const int half = ui >> 8, it = ui & 255, xcd = it & 7, slot = it >> 3, bh = xcd * 4 + (slot >> 3), p = slot & 7, qb = half ? p : 15 - p, b = bh >> 3, h = bh & 7;
            const size_t qrow = (size_t)b * SEQ + 256 * qb, krow = (size_t)b * SEQ;
#ifndef NO_M2
            att::attn_unit<2>(lds, QB + qrow * QW + h * 128, QB + qrow * QW + 1024 + h * 64, KVB + krow * KVW + h * 128, KVB + krow * KVW + 1024 + h * 128, KR + krow * 64,
                              OB + qrow * DM + 1024 + h * 128, QW, QW, KVW, DM, 4 * qb + 4, 4 * qb, 0, nullptr);
#endif
        } else {
            const int it = ui - 512, xcd = it & 7, slot = it >> 3, bh = xcd * 4 + (slot >> 4), qb = slot & 15, b = bh >> 3, h = bh & 7;
            const int qc0 = 4 * qb, kc0 = qc0 > 8 ? qc0 - 8 : 0;
            const size_t qrow = (size_t)b * SEQ + 256 * qb, krow = (size_t)b * SEQ + 64 * kc0;
#ifndef NO_M1
            att::attn_unit<1>(lds, PROJ + qrow * INP + h * 128, nullptr, PROJ + krow * INP + 1024 + h * 128, PROJ + krow * INP + 2048 + h * 128, nullptr,
                              OB + qrow * DM + h * 128, INP, 0, INP, DM, qc0 + 4 - kc0, qc0, kc0, (const float*)a.in[5] + ((size_t)l * 8 + h) * 257);
#endif
        }
    }
}
__device__ __forceinline__ void attn_cross_phase(const Args& a, char* lds, int l) {
    unsigned char* ws = a.ws;
    const bf16* QX = (const bf16*)(ws + WS_QX); const bf16* MKV = (const bf16*)(ws + WS_MEMKV); bf16* OX = (bf16*)(ws + WS_OX);
#pragma unroll 1
    for (int ui = blockIdx.x; ui < 256; ui += gridDim.x) {
        const int xcd = ui & 7, slot = ui >> 3, bh = xcd * 2 + (slot >> 4), qb = slot & 15, b = bh >> 2, h = bh & 3;
        const size_t qrow = (size_t)b * SEQ + 256 * qb, krow = (size_t)b * NMEM;
#ifndef NO_M0
        att::attn_unit<0>(lds, QX + qrow * XW + h * 128, nullptr, MKV + krow * 4096 + l * 1024 + h * 128, MKV + krow * 4096 + l * 1024 + 512 + h * 128, nullptr,
                          OX + qrow * XW + h * 128, XW, 0, 4096, XW, 4, 0, 0, nullptr);
#endif
    }
}

__global__ void __launch_bounds__(NWAVES * 64) mega_fwd(Args a) {
    extern __shared__ __attribute__((aligned(16))) unsigned char lds[];
    cg::grid_group grid = cg::this_grid();
    LAS unsigned char* ldsl = (LAS unsigned char*)lds;
    unsigned char* ws = a.ws;
    float* ss = (float*)(ws + WS_SS);
    const float* cs = (const float*)(ws + WS_COS); const float* sn = (const float*)(ws + WS_SIN);
    bf16* XB = (bf16*)(ws + WS_XB); bf16* PROJ = (bf16*)(ws + WS_PROJ); bf16* QB = (bf16*)(ws + WS_QB); bf16* KVB = (bf16*)(ws + WS_KVB);
    bf16* OB = (bf16*)(ws + WS_OB); bf16* QX = (bf16*)(ws + WS_QX); bf16* OX = (bf16*)(ws + WS_OX); bf16* HFF = (bf16*)(ws + WS_HFF);
    const int G = gridDim.x, c = blockIdx.x;
#define GRID_SYNC() do { asm volatile("s_waitcnt vmcnt(0) lgkmcnt(0)" ::: "memory"); __syncthreads(); \
        if (threadIdx.x < 64) { __builtin_amdgcn_fence(__ATOMIC_RELEASE, "agent"); asm volatile("s_waitcnt vmcnt(0)" ::: "memory"); }     \
        __syncthreads(); grid.sync(); \
        __builtin_amdgcn_fence(__ATOMIC_ACQUIRE, "agent"); asm volatile("s_waitcnt vmcnt(0)" ::: "memory"); __syncthreads(); } while (0)

    unsigned* barw = (unsigned*)(ws + WS_BAR);
    if (threadIdx.x < 2) ((volatile LAS unsigned*)(ldsl + LDS_BARST))[threadIdx.x] = 0u;
    __syncthreads();
    const XcdBarrier xbar = xcd_barrier_post(barw, (volatile LAS unsigned*)(ldsl + LDS_BARST));
    if (a.ws == nullptr) GRID_SYNC();
    prologue(a, ldsl);
#ifdef PROBE_DUP_PRO
    __syncthreads(); prologue(a, ldsl);
#endif
    xcd_barrier(xbar);

#pragma unroll 1
    for (int s = 0; s < 1 + DEPTH * 10; ++s) {
        const int l = s == 0 ? 0 : (s - 1) / 10, st = s == 0 ? -1 : (s - 1) % 10;
        unsigned char* wl = ws + WS_W + (size_t)l * W_LAYER;
        int kind; bool sync_after = true;
        pg8::Gemm g{nullptr, nullptr, M, 0, 0, 0, 0};
        pg8::EpiBf eb{nullptr, 0, nullptr, 0.f, 8, 0, 1.f, nullptr, 0, 0, nullptr, 0, 0, 1 << 30, nullptr, 0, 0, cs, sn, (LAS float*)(ldsl + LDS_RSTAB), -1};
        pg8::EpiRes er{nullptr, (_Float16*)XB, nullptr, DM, 0};
        if (st == -1) {
            kind = 0; g = pg8::Gemm{(const bf16*)(ws + WS_MEMN), (const bf16*)(ws + WS_WXKV), BATCH * NMEM, 4096, DM, DM, DM};
            eb.O = (bf16*)(ws + WS_MEMKV); eb.ldc = 4096; sync_after = false;
        } else if (st == 0) {
            kind = 0; g = pg8::Gemm{XB, (const bf16*)(wl + WO_IN), M, INP, DM, DM, DM};
            eb.O = PROJ; eb.ldc = INP; eb.ss = ss + (size_t)(l * 3 + SS_MIX) * M * 32; eb.inv_w = 1.f / DM; eb.nscale = 4; eb.scale = 0.08838834764831845f * LOG2E;
            eb.ssA = ss + (size_t)(SS_Q + l) * M * 32; eb.a_lo = 12; eb.a_hi = 15; eb.ssB = ss + (size_t)(SS_KV + l) * M * 32; eb.b_lo = 15; eb.b_hi = 17;
            eb.rope_lo = 17; eb.R = (bf16*)(ws + WS_KR); eb.ldr = 64; eb.rmode = 0;
        } else if (st == 1) {
            kind = 0; g = pg8::Gemm{PROJ + 3072, (const bf16*)(wl + WO_UQ), M, QW, 768, INP, 768};
            eb.O = QB; eb.ldc = QW; eb.ss = ss + (size_t)(SS_Q + l) * M * 32; eb.inv_w = 1.f / 768.f; eb.nsl4 = 3; eb.nscale = 6; eb.scale = 0.07216878364870322f * LOG2E;
            eb.rope_lo = 4; eb.R = QB + 1024; eb.ldr = QW; eb.rmode = 1; sync_after = false;
        } else if (st == 2) {
            kind = 0; g = pg8::Gemm{PROJ + 3840, (const bf16*)(wl + WO_UKV), M, KVW, 512, INP, 512};
            eb.O = KVB; eb.ldc = KVW; eb.ss = ss + (size_t)(SS_KV + l) * M * 32; eb.inv_w = 1.f / 512.f; eb.nsl4 = 2;
        } else if (st == 3) { kind = 3;
        } else if (st == 4) {
            kind = 1; g = pg8::Gemm{OB, (const bf16*)(wl + WO_OUT), M, DM, DM, DM, DM};
            er.base32 = nullptr;
            er.ssn = ss + (size_t)(l * 3 + SS_MEM) * M * 32;
        } else if (st == 5) {
            kind = 0; g = pg8::Gemm{XB, (const bf16*)(wl + WO_XQ), M, XW, DM, DM, DM};
            eb.O = QX; eb.ldc = XW; eb.ss = ss + (size_t)(l * 3 + SS_MEM) * M * 32; eb.inv_w = 1.f / DM; eb.nscale = 2; eb.scale = 0.08838834764831845f * LOG2E;
        } else if (st == 6) { kind = 4;
        } else if (st == 7) {
            kind = 1; g = pg8::Gemm{OX, (const bf16*)(wl + WO_XO), M, DM, XW, XW, XW};
            er.ssn = ss + (size_t)(l * 3 + SS_FFN) * M * 32;
        } else if (st == 8) {
            kind = 2; g = pg8::Gemm{XB, (const bf16*)(wl + WO_GU), M, 2 * DFF, DM, DM, DM};
        } else {
            kind = 1; g = pg8::Gemm{HFF, (const bf16*)(wl + WO_D), M, DM, DFF, DFF, DFF};
            er.ssn = ss + (size_t)(l == DEPTH - 1 ? SS_FINAL : (l + 1) * 3 + SS_MIX) * M * 32;
        }
#ifdef PROBE_DUP_ST
        const int reps = (st >= 0 && ((PROBE_DUP_ST >> st) & 1)) ? 2 : 1;
#else
        const int reps = 1;
#endif
#pragma unroll 1
        for (int rep = 0; rep < reps; ++rep) {
#ifdef PROBE_DUP_ST
        if (rep == 1 && kind == 1) { er.base32 = nullptr; er.xh = (_Float16*)KVB; er.ssn = (float*)(ws + WS_QX);
#ifdef PROBE_PF
            er.pf = PROBE_PF;
#endif
#ifdef PROBE_LDC
            er.ldc = PROBE_LDC;
#endif
        }
#endif
        if (kind <= 2) {
#ifndef NO_GEMM
            pg8::StaticOrder S; S.init(g.M, g.N, G, c, (kind == 1 && (g.M / 256) % 8 == 0) ? 1 : 0);
            if (kind == 0 && (st == 0 || st == 5)) pg8::gemm_phase<pg8::EpiBf, pg8::StaticOrder, true, true, true>(ldsl, g, S, eb);
            else if (kind == 0) pg8::gemm_phase<pg8::EpiBf, pg8::StaticOrder, true, true>(ldsl, g, S, eb);
            else if (kind == 1) pg8::gemm_phase<pg8::EpiRes, pg8::StaticOrder, true, true>(ldsl, g, S, er);
            else { pg8::EpiGU eg{HFF, DFF, ss + (size_t)(l * 3 + SS_FFN) * M * 32, 1.f / DM, (LAS float*)(ldsl + LDS_RSTAB), -1}; pg8::gemm_phase<pg8::EpiGU, pg8::StaticOrder, true, true, true>(ldsl, g, S, eg); }
#endif
            if ((int)blockIdx.x >= G / 2 && rep == 0) {
                if (st == 0) convert_range(a, ldsl, l, IT_EARLY, IT_SLOT_A);
                else if (st == 1) convert_range(a, ldsl, l, IT_SLOT_A, IT_SLOT_D);
                else if (st == 5) convert_range(a, ldsl, l, IT_SLOT_D, IT_LAYER);
            }
        }
#ifndef NO_ATT
#ifdef PROBE_SKIP
        else if (kind == 3) attn_mix_phase(a, (char*)lds, l, rep == 1 ? PROBE_SKIP : 0);
#else
        else if (kind == 3) attn_mix_phase(a, (char*)lds, l);
#endif
        else attn_cross_phase(a, (char*)lds, l);
#endif
        }
        if (sync_after) xcd_barrier(xbar); else __syncthreads();
    }
    {
        int tid = threadIdx.x; asm volatile("" : "+v"(tid));
        const int lane = tid & 63, wave = tid >> 6, gw = c * NWAVES + wave, NGW = G * NWAVES;
        typedef _Float16 f16x4v __attribute__((ext_vector_type(4)));
        const f32x4* gr = (const f32x4*)a.in[20] + lane;
        for (int m = gw; m < M; m += NGW) {
            float sv = ss[((size_t)SS_FINAL * M + m) * 32 + (lane & 31)];
#pragma unroll
            for (int o = 1; o < 32; o <<= 1) sv += __shfl_xor(sv, o);
            const float rstd = 1.f / sqrtf(sv * (1.f / DM) + EPS);
            const f16x4v* xr = (const f16x4v*)((const _Float16*)XB + (size_t)m * DM) + lane;
            f32x4* orow = (f32x4*)(a.out + (size_t)m * DM) + lane;
#pragma unroll
            for (int j = 0; j < 8; ++j) { const f32x4 v = __builtin_convertvector(xr[64 * j], f32x4), gg = gr[64 * j]; orow[64 * j] = v * rstd * gg; }
        }
    }
}

extern "C" void kernel_launch(void* const* d_in, const int* in_sizes, int n_in, void* d_out, int out_size, void* d_ws, size_t ws_size, hipStream_t stream) {
    static int grid = 0;
    if (grid == 0) {
        if (n_in != 21 || out_size != M * DM || ws_size < WS_END) { fprintf(stderr, "kernel_launch: unexpected shapes: n_in %d out %d ws %zu (need %zu)\n", n_in, out_size, ws_size, (size_t)WS_END); grid = -1; return; }
        int dev = 0, cus = 0, per_cu = 0;
        hipGetDevice(&dev); hipDeviceGetAttribute(&cus, hipDeviceAttributeMultiprocessorCount, dev);
        if (hipFuncSetAttribute((const void*)mega_fwd, hipFuncAttributeMaxDynamicSharedMemorySize, LDS_BYTES) != hipSuccess) { fprintf(stderr, "kernel_launch: hipFuncSetAttribute failed\n"); grid = -1; return; }
        if (hipOccupancyMaxActiveBlocksPerMultiprocessor(&per_cu, (const void*)mega_fwd, NWAVES * 64, LDS_BYTES) != hipSuccess || per_cu < 1) { fprintf(stderr, "kernel_launch: occupancy query says %d\n", per_cu); per_cu = 1; }
        (void)hipGetLastError();
        grid = cus;
    }
    if (grid < 0) return;
    if (hipMemsetAsync((char*)d_ws + WS_BAR, 0, XCD_BAR_WORDS * 4, stream) != hipSuccess) { fprintf(stderr, "kernel_launch: hipMemsetAsync failed\n"); return; }
    Args a{};
    for (int i = 0; i < 21; ++i) a.in[i] = d_in[i];
    a.out = (float*)d_out; a.ws = (unsigned char*)d_ws;
    void* args[] = {&a};
    hipError_t e = hipLaunchCooperativeKernel((const void*)mega_fwd, dim3(grid), dim3(NWAVES * 64), args, LDS_BYTES, stream);
    if (e != hipSuccess) fprintf(stderr, "kernel_launch: cooperative launch failed: %s (grid %d)\n", hipGetErrorString(e), grid);
}
```
